# Optimizing an MI355X kernel written in HIP

```python
import jax, jax.numpy as jnp
from jax import lax
import numpy as np

D_MODEL = 1024
BATCH = 1
SEQ = 16384
DEPTH = 4

D_MIX = 1024
MLA_HEADS = 8
QK_NOPE = 64
QK_ROPE = 32
QK_HEAD = QK_NOPE + QK_ROPE
V_HEAD = 64
Q_LORA = 384
KV_LORA = 256
MLA_WIDTH = MLA_HEADS * V_HEAD
ROPE_THETA = 10000.0
Q_BLOCK = 128
POOL_WINDOWS = (2, 4, 8, 16)
POOL_GROUPS = len(POOL_WINDOWS)
POOL_WIDTH = D_MIX - MLA_WIDTH
POOL_GROUP_DIM = POOL_WIDTH // POOL_GROUPS
D_IN = Q_LORA + KV_LORA + QK_ROPE + POOL_WIDTH
D_FF = 2816
EPS = 1e-6

kernel_name = "hybrid_mla_pool_macaron_encoder"


def rmsnorm(x, g):
    xf = x.astype(jnp.float32)
    y = xf * lax.rsqrt(jnp.mean(xf * xf, axis=-1, keepdims=True) + EPS)
    return (y * g.astype(jnp.float32)).astype(x.dtype)


def swiglu(h, w_gu, w_down):
    gu = h @ w_gu
    g, u = gu[..., :D_FF], gu[..., D_FF:]
    return (jax.nn.silu(g) * u) @ w_down


def rope_tables(seq):
    pos = jnp.arange(seq, dtype=jnp.float32)
    inv = ROPE_THETA ** (-jnp.arange(0, QK_ROPE, 2, dtype=jnp.float32) / QK_ROPE)
    ang = pos[:, None] * inv[None, :]
    return jnp.cos(ang), jnp.sin(ang)


def apply_rope(t, cos, sin):
    tf = t.astype(jnp.float32)
    half = QK_ROPE // 2
    t1, t2 = tf[..., :half], tf[..., half:]
    c, s = cos[None, :, None, :], sin[None, :, None, :]
    out = jnp.concatenate([t1 * c - t2 * s, t2 * c + t1 * s], axis=-1)
    return out.astype(t.dtype)


def bidir_attention(q, k, v):
    B, S, H, Dq = q.shape
    nb = S // Q_BLOCK
    qb = jnp.moveaxis((q * (Dq ** -0.5)).reshape(B, nb, Q_BLOCK, H, Dq), 1, 0)

    def block(q_blk):
        s = jnp.einsum('bqhd,bkhd->bhqk', q_blk, k, preferred_element_type=jnp.float32)
        p = jax.nn.softmax(s, axis=-1).astype(v.dtype)
        return jnp.einsum('bhqk,bkhd->bqhd', p, v)

    o = lax.map(block, qb)
    return jnp.moveaxis(o, 0, 1).reshape(B, S, H * V_HEAD)


def mla_mixer(c_q, c_kv, k_pe, q_lat_norm, kv_lat_norm, w_uq, w_uk, w_uv, q_norm, k_norm, cos, sin):
    B, S, _ = c_q.shape
    c_q = rmsnorm(c_q, q_lat_norm)
    c_kv = rmsnorm(c_kv, kv_lat_norm)
    q = (c_q @ w_uq).reshape(B, S, MLA_HEADS, QK_HEAD)
    k_nope = (c_kv @ w_uk).reshape(B, S, MLA_HEADS, QK_NOPE)
    v = (c_kv @ w_uv).reshape(B, S, MLA_HEADS, V_HEAD)
    k_pe_h = jnp.broadcast_to(k_pe[:, :, None, :], (B, S, MLA_HEADS, QK_ROPE))
    k = jnp.concatenate([k_nope, k_pe_h], axis=-1)
    q = rmsnorm(q, q_norm)
    k = rmsnorm(k, k_norm)
    q = jnp.concatenate([q[..., :QK_NOPE], apply_rope(q[..., QK_NOPE:], cos, sin)], axis=-1)
    k = jnp.concatenate([k[..., :QK_NOPE], apply_rope(k[..., QK_NOPE:], cos, sin)], axis=-1)
    return bidir_attention(q, k, v)


def pool_mixer(p, w_pool, pool_scale):
    B, S, C = p.shape
    pf = p.astype(jnp.float32)
    cs = jnp.concatenate([jnp.zeros((B, 1, C), jnp.float32), jnp.cumsum(pf, axis=1)], axis=1)
    idx = jnp.arange(S)
    outs = []
    for g, w in enumerate(POOL_WINDOWS):
        left = w // 2
        right = w - 1 - left
        lo = jnp.clip(idx - left, 0, S)
        hi = jnp.clip(idx + right + 1, 0, S)
        csg = cs[..., g * POOL_GROUP_DIM:(g + 1) * POOL_GROUP_DIM]
        wsum = jnp.take(csg, hi, axis=1) - jnp.take(csg, lo, axis=1)
        cnt = (hi - lo).astype(jnp.float32)[None, :, None]
        outs.append(wsum / cnt)
    pooled = jnp.stack(outs, axis=2)
    mixed = (pooled - pf.reshape(B, S, POOL_GROUPS, POOL_GROUP_DIM)).astype(p.dtype)
    y = jnp.einsum('bsgc,gcd->bsgd', mixed, w_pool).reshape(B, S, C)
    return y * pool_scale


def setup_inputs(seed: int = 0) -> dict:
    key = jax.random.key(seed)
    ks = jax.random.split(key, 20)
    f32 = jnp.float32

    def w(k, shape, fan_in):
        return jax.random.normal(k, shape, f32) * (fan_in ** -0.5)

    def gain(k, shape):
        return 1.0 + 0.02 * jax.random.normal(k, shape, f32)

    return {
        "x": jax.random.normal(ks[0], (BATCH, SEQ, D_MODEL), f32),
        "ffn1_norm": gain(ks[1], (DEPTH, D_MODEL)),
        "ffn1_w_gu": w(ks[2], (DEPTH, D_MODEL, 2 * D_FF), D_MODEL),
        "ffn1_w_down": w(ks[3], (DEPTH, D_FF, D_MODEL), D_FF),
        "mix_norm": gain(ks[4], (DEPTH, D_MODEL)),
        "w_in": w(ks[5], (DEPTH, D_MODEL, D_IN), D_MODEL),
        "q_lat_norm": gain(ks[6], (DEPTH, Q_LORA)),
        "kv_lat_norm": gain(ks[7], (DEPTH, KV_LORA)),
        "w_uq": w(ks[8], (DEPTH, Q_LORA, MLA_HEADS * QK_HEAD), Q_LORA),
        "w_uk": w(ks[9], (DEPTH, KV_LORA, MLA_HEADS * QK_NOPE), KV_LORA),
        "w_uv": w(ks[10], (DEPTH, KV_LORA, MLA_HEADS * V_HEAD), KV_LORA),
        "q_norm": gain(ks[11], (DEPTH, QK_HEAD)),
        "k_norm": gain(ks[12], (DEPTH, QK_HEAD)),
        "w_pool": w(ks[13], (DEPTH, POOL_GROUPS, POOL_GROUP_DIM, POOL_GROUP_DIM), POOL_GROUP_DIM),
        "pool_scale": gain(ks[14], (DEPTH, POOL_WIDTH)),
        "w_out": w(ks[15], (DEPTH, D_MIX, D_MODEL), D_MIX),
        "ffn2_norm": gain(ks[16], (DEPTH, D_MODEL)),
        "ffn2_w_gu": w(ks[17], (DEPTH, D_MODEL, 2 * D_FF), D_MODEL),
        "ffn2_w_down": w(ks[18], (DEPTH, D_FF, D_MODEL), D_FF),
    }


def reference(x, ffn1_norm, ffn1_w_gu, ffn1_w_down, mix_norm, w_in, q_lat_norm, kv_lat_norm,
              w_uq, w_uk, w_uv, q_norm, k_norm, w_pool, pool_scale, w_out,
              ffn2_norm, ffn2_w_gu, ffn2_w_down):
    S = x.shape[1]
    cos, sin = rope_tables(S)
    o_kv = Q_LORA
    o_pe = Q_LORA + KV_LORA
    o_pool = Q_LORA + KV_LORA + QK_ROPE
    for l in range(DEPTH):
        x = x + 0.5 * swiglu(rmsnorm(x, ffn1_norm[l]), ffn1_w_gu[l], ffn1_w_down[l])
        z = rmsnorm(x, mix_norm[l]) @ w_in[l]
        a = mla_mixer(z[..., :o_kv], z[..., o_kv:o_pe], z[..., o_pe:o_pool],
                      q_lat_norm[l], kv_lat_norm[l], w_uq[l], w_uk[l], w_uv[l],
                      q_norm[l], k_norm[l], cos, sin)
        b = pool_mixer(z[..., o_pool:], w_pool[l], pool_scale[l])
        x = x + jnp.concatenate([a, b], axis=-1) @ w_out[l]
        x = x + 0.5 * swiglu(rmsnorm(x, ffn2_norm[l]), ffn2_w_gu[l], ffn2_w_down[l])
    return x
```

```cpp
#include <hip/hip_runtime.h>
#include <hip/hip_cooperative_groups.h>
#include <cstdio>
#include <cstdint>
namespace cg = cooperative_groups;

#define LAS __attribute__((address_space(3)))
typedef unsigned short bf16_t;
typedef short bf16x8 __attribute__((ext_vector_type(8)));
typedef float f32x4 __attribute__((ext_vector_type(4)));
typedef float f32x16 __attribute__((ext_vector_type(16)));
typedef unsigned u32x4 __attribute__((ext_vector_type(4)));
typedef unsigned u32x2 __attribute__((ext_vector_type(2)));
typedef float f32x2_t __attribute__((ext_vector_type(2)));
typedef __bf16 bf16x2_t __attribute__((ext_vector_type(2)));

constexpr int SEQ = 16384, DM = 1024, DEPTH = 4, NH = 8, QKN = 64, QKR = 32, QKH = 96, VH = 64, QL = 384, KVL = 256;
constexpr int PW = 512, DIN = 1184, DINP = 1280, DFF = 2816, ZC = QL + KVL  , ZR = QKR + PW  ;
constexpr float EPS = 1e-6f;
constexpr float QSCALE = 0.14724444602590306f;

constexpr size_t E_WGU = (size_t)2 * DFF * DM, E_WD = (size_t)DM * DFF, E_WIN = (size_t)DINP * DM, E_WUQ = (size_t)768 * QL, E_WUKV = (size_t)1024 * KVL,
                 E_WPOOL = (size_t)512 * 512, E_WOUT = (size_t)DM * DM;
constexpr size_t O_WGU1 = 0, O_WD1 = O_WGU1 + E_WGU, O_WIN = O_WD1 + E_WD, O_WUQ = O_WIN + E_WIN, O_WUKV = O_WUQ + E_WUQ, O_WPOOL = O_WUKV + E_WUKV,
                 O_WOUT = O_WPOOL + E_WPOOL, O_WGU2 = O_WOUT + E_WOUT, O_WD2 = O_WGU2 + E_WGU, E_WALL = O_WD2 + E_WD;
constexpr size_t al256(size_t x) { return (x + 255) & ~(size_t)255; }
constexpr size_t WS_W = 0;
constexpr size_t WS_W2 = al256(WS_W + E_WALL * 2);
constexpr size_t WS_HN = al256(WS_W2 + E_WALL * 2);
constexpr size_t WS_ACT = WS_HN + (size_t)SEQ * DM * 2;
constexpr size_t WS_QP = WS_HN;
constexpr size_t WS_KVP = WS_QP + (size_t)SEQ * 768 * 4;
constexpr size_t WS_ZC = al256(WS_ACT + (size_t)SEQ * DFF * 2);
constexpr size_t WS_ZR = WS_ZC + (size_t)SEQ * ZC * 2;
constexpr size_t WS_MIX = WS_ZR + (size_t)SEQ * ZR * 4;
constexpr size_t WS_RQ = WS_MIX + (size_t)SEQ * PW * 2;
constexpr size_t WS_RKV = WS_RQ + (size_t)SEQ * 4;
constexpr size_t WS_ROPE = WS_RKV + (size_t)SEQ * 4;
constexpr size_t WS_SS = WS_ROPE + (size_t)SEQ * 32 * 4;
constexpr size_t WS_Q = WS_SS + (size_t)(DEPTH * 3 + 1) * SEQ * 8;
constexpr size_t WS_K = WS_Q + (size_t)NH * SEQ * QKH * 2;
constexpr size_t WS_V = WS_K + (size_t)NH * SEQ * QKH * 2;
constexpr size_t WS_AB = WS_V + (size_t)NH * SEQ * VH * 2;
constexpr size_t WS_CTL = WS_AB + (size_t)SEQ * DM * 2;
constexpr size_t CTL_BYTES = 16384;
constexpr size_t WS_END = WS_CTL + CTL_BYTES;
static_assert(WS_END <= (size_t)390140864, "workspace map exceeds the guaranteed d_ws size (sum of the input bytes)");
static_assert(WS_KVP + (size_t)SEQ * 1024 * 4 <= WS_ZC, "q'/kv' alias inside hn|act");

constexpr int LDS_BYTES = 135168;

__device__ __forceinline__ unsigned cvtpk(float lo, float hi) { f32x2_t v = {lo, hi}; bf16x2_t b = __builtin_convertvector(v, bf16x2_t); return __builtin_bit_cast(unsigned, b); }
__device__ __forceinline__ float bf2f(unsigned short b) { return __builtin_bit_cast(float, (unsigned)b << 16); }
__device__ __forceinline__ float bflo(unsigned w) { return __builtin_bit_cast(float, w << 16); }
__device__ __forceinline__ float bfhi(unsigned w) { return __builtin_bit_cast(float, w & 0xffff0000u); }
__device__ __forceinline__ float wave_sum(float v) {
#pragma unroll
    for (int o = 1; o < 64; o <<= 1) v += __shfl_xor(v, o);
    return v;
}
typedef unsigned long long u64;
constexpr float SSF = 16777216.f, SSFI = 1.f / 16777216.f;
__device__ __forceinline__ float ss_rs(u64 v) { return 1.f / sqrtf((float)v * (SSFI / 1024.f) + 1e-6f); }
__device__ __forceinline__ int fresh_tid(int wave_k) { unsigned ones = ~0u; asm volatile("" : "+s"(ones)); const int l = (int)__builtin_amdgcn_mbcnt_hi(ones, __builtin_amdgcn_mbcnt_lo(ones, 0u)); return wave_k * 64 + l; }
#define LDS_WAIT() asm volatile("s_waitcnt lgkmcnt(0)" ::: "memory")

namespace pg8 {
constexpr int BM = 256, BK = 64, HALF = 128, HTB = HALF * BK * 2, STAGE_BYTES = 8 * HTB, NXCD = 8, WGM = 8;
__device__ __forceinline__ int lds_byte(int r, int c) { const int st = (r >> 4) * 2 + (c >> 5), rr = r & 15, cc = c & 31, ob = rr * 64 + cc * 2; return st * 1024 + (ob ^ (((ob >> 9) & 1) << 5)); }
__device__ __forceinline__ void stage_rc(int b, int& R, int& C) { const int st = b / 1024, sb = b % 1024, swz = sb ^ (((sb >> 9) & 1) << 5); R = (st >> 1) * 16 + swz / 64; C = (st & 1) * 32 + (swz % 64) / 2; }
__device__ __forceinline__ int perm32(int rho) { const int n = rho >> 4, i = rho & 15; return 8 * (i >> 2) + 4 * n + (i & 3); }
struct Unit { int pm, pn; };
struct Gemm { const bf16_t* A; const bf16_t* Bt; int M, N, K, lda; };
struct StaticOrder {
    int nM, nN, nwg, G, c;
    __device__ void init(int M, int N, int G_, int c_) { nM = M / BM; nN = N / BM; nwg = nM * nN; G = G_; c = c_; }
    __device__ bool next(int i, Unit& u) const {
        const long L = (long)i * G + c; if (L >= nwg) return false;
        int wgid = (int)L; { const int q = nwg / NXCD, r = nwg % NXCD, xcd = wgid % NXCD, off = wgid / NXCD; wgid = (xcd < r ? xcd * (q + 1) : r * (q + 1) + (xcd - r) * q) + off; }
        const int nig = WGM * nN, gid = wgid / nig, fm = gid * WGM, gsz = (nM - fm) < WGM ? (nM - fm) : WGM;
        u.pm = fm + ((wgid % nig) % gsz); u.pn = (wgid % nig) / gsz; return true;
    }
};
template <class Epi, bool ALIGN_EPI = true>
__device__ __forceinline__ void gemm_phase(LAS unsigned char* lds, const Gemm g, const StaticOrder& S, const Epi& E, int wave_k) {
    const int tid = fresh_tid(wave_k);
    const int wid = __builtin_amdgcn_readfirstlane(tid >> 6), lane = tid & 63, wr = wid >> 2, wc = wid & 3, fr = lane & 15, fq = lane >> 4;
    const int K = g.K, nt = K / BK, lda = g.lda;
    unsigned voffA[2], voffB[2];
#pragma unroll
    for (int i = 0; i < 2; ++i) { int R, C; stage_rc(tid * 16 + i * 8192, R, C); const int Rb = (R & ~31) + perm32(R & 31);
        voffA[i] = (unsigned)(R * lda + C) * 2u; voffB[i] = (unsigned)(Rb * K + C) * 2u; }
    const size_t kstep = (size_t)(BK * 2);
    const size_t hstepA = (size_t)HALF * lda * 2, hstepB = (size_t)HALF * K * 2;
    const size_t tstepA = 2 * hstepA, tstepB = 2 * hstepB;
    const unsigned ldsw = (unsigned)wid * 1024u;
    const int aoff = lds_byte(wr * 64 + fr, fq * 8), boff = lds_byte(wc * 32 + fr, fq * 8);
#define PG8_SA(b, h) (((b) * 2 + (h)) * HTB)
#define PG8_SB(b, h) ((4 + (b) * 2 + (h)) * HTB)
#define PG8_STAGE(bufoff, gbase, voff) do { _Pragma("unroll") for (int _i = 0; _i < 2; ++_i) \
        __builtin_amdgcn_global_load_lds((const unsigned*)((const char*)(gbase) + (voff)[_i]), (LAS unsigned*)(lds + (bufoff) + ldsw + _i * 8192), 16, 0, 0); } while (0)
#define PG8_LDA(dst, b, h) do { _Pragma("unroll") for (int m = 0; m < 4; ++m) _Pragma("unroll") for (int k = 0; k < 2; ++k) dst[m][k] = *(const LAS bf16x8*)(lds + PG8_SA(b, h) + aoff + m * 2048 + k * 1024); } while (0)
#define PG8_LDB(dst, b, h) do { _Pragma("unroll") for (int n = 0; n < 2; ++n) _Pragma("unroll") for (int k = 0; k < 2; ++k) dst[n][k] = *(const LAS bf16x8*)(lds + PG8_SB(b, h) + boff + n * 2048 + k * 1024); } while (0)
#define PG8_MMA(ai, bj, At, Bt) do { __builtin_amdgcn_s_setprio(1); _Pragma("unroll") for (int m = 0; m < 4; ++m) _Pragma("unroll") for (int n = 0; n < 2; ++n) _Pragma("unroll") for (int k = 0; k < 2; ++k) \
        acc[ai][bj][m][n] = __builtin_amdgcn_mfma_f32_16x16x32_bf16(Bt[n][k], At[m][k], acc[ai][bj][m][n], 0, 0, 0); __builtin_amdgcn_s_setprio(0); } while (0)
#define PG8_WAIT_V(n) asm volatile("s_waitcnt vmcnt(" #n ")" ::: "memory")
#define PG8_WAIT_L(n) asm volatile("s_waitcnt lgkmcnt(" #n ")" ::: "memory")
#define PG8_BAR __builtin_amdgcn_s_barrier()
#define PG8_SCHED __builtin_amdgcn_sched_barrier(0)
    Unit cur, nxt; int ui = 0;
    if (!S.next(0, cur)) return;
    f32x4 acc[2][2][4][2];
#pragma unroll
    for (int a = 0; a < 2; ++a)
#pragma unroll
        for (int b = 0; b < 2; ++b)
#pragma unroll
            for (int m = 0; m < 4; ++m)
#pragma unroll
                for (int n = 0; n < 2; ++n) acc[a][b][m][n] = (f32x4){0.f, 0.f, 0.f, 0.f};
    bf16x8 At[4][2], B0[2][2], B1[2][2];
    const char* cA = (const char*)g.A + (size_t)cur.pm * tstepA; const char* cB = (const char*)g.Bt + (size_t)cur.pn * tstepB;
    PG8_STAGE(PG8_SB(0, 0), cB, voffB); PG8_STAGE(PG8_SB(0, 1), cB + hstepB, voffB); PG8_STAGE(PG8_SA(0, 0), cA, voffA); PG8_STAGE(PG8_SA(0, 1), cA + hstepA, voffA);
    if (wr == 1) PG8_BAR;
    PG8_WAIT_V(2); PG8_BAR;
    PG8_STAGE(PG8_SB(1, 0), cB + kstep, voffB); PG8_STAGE(PG8_SA(1, 0), cA + kstep, voffA); PG8_STAGE(PG8_SB(1, 1), cB + hstepB + kstep, voffB);
    PG8_WAIT_V(6); PG8_BAR;
    for (;;) {
        const bool has_next = S.next(ui + 1, nxt);
        const char* nA = has_next ? (const char*)g.A + (size_t)nxt.pm * tstepA : cA; const char* nB = has_next ? (const char*)g.Bt + (size_t)nxt.pn * tstepB : cB;
        for (int t = 0; t < nt; t += 2) {
            const bool last = (t == nt - 2);
            const char* a1 = cA + (size_t)(t + 1) * kstep;
            const char* a2 = last ? nA : cA + (size_t)(t + 2) * kstep; const char* b2 = last ? nB : cB + (size_t)(t + 2) * kstep;
            const char* a3 = a2 + kstep; const char* b3 = b2 + kstep;
            PG8_LDB(B0, 0, 0); PG8_LDB(B1, 0, 1); PG8_SCHED; PG8_LDA(At, 0, 0); PG8_STAGE(PG8_SA(1, 1), a1 + hstepA, voffA);
            PG8_WAIT_V(8); PG8_WAIT_L(0); PG8_BAR; PG8_MMA(0, 0, At, B0); PG8_MMA(0, 1, At, B1); PG8_BAR; PG8_SCHED;
            PG8_LDA(At, 0, 1); PG8_STAGE(PG8_SB(0, 0), b2, voffB); PG8_STAGE(PG8_SB(0, 1), b2 + hstepB, voffB); PG8_STAGE(PG8_SA(0, 0), a2, voffA);
            PG8_WAIT_V(8); PG8_WAIT_L(0); PG8_BAR; PG8_MMA(1, 0, At, B0); PG8_MMA(1, 1, At, B1); PG8_BAR; PG8_SCHED;
            PG8_LDB(B0, 1, 0); PG8_LDB(B1, 1, 1); PG8_SCHED; PG8_LDA(At, 1, 0); PG8_STAGE(PG8_SA(0, 1), a2 + hstepA, voffA);
            PG8_WAIT_V(8); PG8_WAIT_L(0); PG8_BAR; PG8_MMA(0, 0, At, B0); PG8_MMA(0, 1, At, B1); PG8_BAR; PG8_SCHED;
            PG8_LDA(At, 1, 1); PG8_STAGE(PG8_SB(1, 0), b3, voffB); PG8_STAGE(PG8_SB(1, 1), b3 + hstepB, voffB); PG8_STAGE(PG8_SA(1, 0), a3, voffA);
            PG8_WAIT_V(8); PG8_WAIT_L(0); PG8_BAR; PG8_MMA(1, 0, At, B0); PG8_MMA(1, 1, At, B1); PG8_BAR; PG8_SCHED;
        }
        if constexpr (ALIGN_EPI) { if (wr == 0) PG8_BAR; }
        E(acc, cur, wr, wc, fr, fq);
        if (wid == 0) asm volatile("buffer_wbl2 sc1" ::: "memory");
        if (!has_next) break;
#pragma unroll
        for (int a = 0; a < 2; ++a)
#pragma unroll
            for (int b = 0; b < 2; ++b)
#pragma unroll
                for (int m = 0; m < 4; ++m)
#pragma unroll
                    for (int n = 0; n < 2; ++n) acc[a][b][m][n] = (f32x4){0.f, 0.f, 0.f, 0.f};
        cur = nxt; cA = nA; cB = nB; ++ui;
        if constexpr (ALIGN_EPI) { if (wr == 1) PG8_BAR; }
    }
    PG8_WAIT_V(0);
    if constexpr (!ALIGN_EPI) { if (wr == 0) PG8_BAR; }
    PG8_BAR;
#undef PG8_SA
#undef PG8_SB
#undef PG8_STAGE
#undef PG8_LDA
#undef PG8_LDB
#undef PG8_MMA
#undef PG8_WAIT_V
#undef PG8_WAIT_L
#undef PG8_BAR
#undef PG8_SCHED
}

typedef f32x4 Acc[2][2][4][2];
struct EpiSwiGLU {
    bf16_t* O; const u64* SS;
    __device__ __forceinline__ void operator()(const Acc& acc, const Unit& u, int wr, int wc, int fr, int fq) const {
        const int row0 = u.pm * BM + wr * 64 + fr, col0 = u.pn * 128 + wc * 32 + 8 * fq;
        u64 sv[2][4];
#pragma unroll
        for (int ai = 0; ai < 2; ++ai)
#pragma unroll
            for (int m = 0; m < 4; ++m) sv[ai][m] = SS[row0 + ai * HALF + m * 16];
#pragma unroll
        for (int ai = 0; ai < 2; ++ai)
#pragma unroll
            for (int m = 0; m < 4; ++m) {
                const int row = row0 + ai * HALF + m * 16; const float rs = ss_rs(sv[ai][m]);
                unsigned w[4];
#pragma unroll
                for (int n = 0; n < 2; ++n) {
                    const f32x4 gv = acc[ai][0][m][n] * rs, uv = acc[ai][1][m][n] * rs; float h[4];
#pragma unroll
                    for (int e = 0; e < 4; ++e) { const float gg = gv[e]; h[e] = gg * __builtin_amdgcn_rcpf(1.f + __builtin_amdgcn_exp2f(-1.4426950408889634f * gg)) * uv[e]; }
                    w[2 * n] = cvtpk(h[0], h[1]); w[2 * n + 1] = cvtpk(h[2], h[3]);
                }
                *(u32x4*)(O + (size_t)row * DFF + col0) = (u32x4){w[0], w[1], w[2], w[3]};
            }
    }
};
struct EpiResid {
    const float* Xin; float* X; bf16_t* XB; u64* SS; float scale;
    __device__ __forceinline__ void operator()(const Acc& acc, const Unit& u, int wr, int wc, int fr, int fq) const {
        const int row0 = u.pm * BM + wr * 64 + fr, col0 = u.pn * BM + wc * 32 + 8 * fq;
#pragma unroll
        for (int ai = 0; ai < 2; ++ai)
#pragma unroll
            for (int m = 0; m < 4; ++m) { const int row = row0 + ai * HALF + m * 16; float* rp = X + (size_t)row * DM + col0; const float* ip = Xin + (size_t)row * DM + col0; bf16_t* bp = XB + (size_t)row * DM + col0; float part = 0.f;
#pragma unroll
                for (int bj = 0; bj < 2; ++bj) { f32x4* p = (f32x4*)(rp + bj * HALF); const f32x4* q = (const f32x4*)(ip + bj * HALF); f32x4 a = q[0], b = q[1]; a += acc[ai][bj][m][0] * scale; b += acc[ai][bj][m][1] * scale; p[0] = a; p[1] = b;
                    *(u32x4*)(bp + bj * HALF) = (u32x4){cvtpk(a[0], a[1]), cvtpk(a[2], a[3]), cvtpk(b[0], b[1]), cvtpk(b[2], b[3])};
                    part += (a[0] * a[0] + a[1] * a[1]) + (a[2] * a[2] + a[3] * a[3]) + (b[0] * b[0] + b[1] * b[1]) + (b[2] * b[2] + b[3] * b[3]); }
                part += __shfl_xor(part, 16); part += __shfl_xor(part, 32);
                if (fq == 0) __hip_atomic_fetch_add(SS + row, (u64)(part * SSF), __ATOMIC_RELAXED, __HIP_MEMORY_SCOPE_AGENT); }
    }
};
struct EpiZ {
    bf16_t* ZCp; float* ZRp; const u64* SS;
    __device__ __forceinline__ void operator()(const Acc& acc, const Unit& u, int wr, int wc, int fr, int fq) const {
        const int row0 = u.pm * BM + wr * 64 + fr, col0 = u.pn * BM + wc * 32 + 8 * fq;
        u64 sv[2][4];
#pragma unroll
        for (int ai = 0; ai < 2; ++ai)
#pragma unroll
            for (int m = 0; m < 4; ++m) sv[ai][m] = SS[row0 + ai * HALF + m * 16];
#pragma unroll
        for (int ai = 0; ai < 2; ++ai)
#pragma unroll
            for (int m = 0; m < 4; ++m) { const size_t row = (size_t)(row0 + ai * HALF + m * 16); const float rs = ss_rs(sv[ai][m]);
#pragma unroll
                for (int bj = 0; bj < 2; ++bj) { const int col = col0 + bj * HALF; const f32x4 a = acc[ai][bj][m][0] * rs, b = acc[ai][bj][m][1] * rs;
                    if (col < ZC) *(u32x4*)(ZCp + row * ZC + col) = (u32x4){cvtpk(a[0], a[1]), cvtpk(a[2], a[3]), cvtpk(b[0], b[1]), cvtpk(b[2], b[3])};
                    else if (col < DIN) { f32x4* p = (f32x4*)(ZRp + row * ZR + (col - ZC)); p[0] = a; p[1] = b; } } }
    }
};
struct EpiF32 {
    float* C; int ldc;
    __device__ __forceinline__ void operator()(const Acc& acc, const Unit& u, int wr, int wc, int fr, int fq) const {
        const int row0 = u.pm * BM + wr * 64 + fr, col0 = u.pn * BM + wc * 32 + 8 * fq;
#pragma unroll
        for (int ai = 0; ai < 2; ++ai)
#pragma unroll
            for (int m = 0; m < 4; ++m) { float* rp = C + (size_t)(row0 + ai * HALF + m * 16) * ldc + col0;
#pragma unroll
                for (int bj = 0; bj < 2; ++bj) { f32x4* p = (f32x4*)(rp + bj * HALF); p[0] = acc[ai][bj][m][0]; p[1] = acc[ai][bj][m][1]; } }
    }
};
struct EpiPool {
    bf16_t* AB; const float* scale;
    __device__ __forceinline__ void operator()(const Acc& acc, const Unit& u, int wr, int wc, int fr, int fq) const {
        const int row0 = u.pm * BM + wr * 64 + fr, col0 = u.pn * BM + wc * 32 + 8 * fq;
#pragma unroll
        for (int ai = 0; ai < 2; ++ai)
#pragma unroll
            for (int m = 0; m < 4; ++m) { const size_t row = (size_t)(row0 + ai * HALF + m * 16);
#pragma unroll
                for (int bj = 0; bj < 2; ++bj) { const int col = col0 + bj * HALF; const f32x4 s0 = *(const f32x4*)(scale + col), s1 = *(const f32x4*)(scale + col + 4);
                    const f32x4 a = acc[ai][bj][m][0] * s0, b = acc[ai][bj][m][1] * s1;
                    *(u32x4*)(AB + row * DM + PW + col) = (u32x4){cvtpk(a[0], a[1]), cvtpk(a[2], a[3]), cvtpk(b[0], b[1]), cvtpk(b[2], b[3])}; } }
    }
};
}

#define XB_TMO      128
#define XB_XCNT(j)  (256  + 64 * (j))
#define XB_XSUB(j)  (1280 + 64 * (j))
#define XB_XGEN(j)  (2304 + 64 * (j))
#define XB_TOP      3328
#define XB_TOPGEN   3392
#define XCD_BAR_WORDS 3456
#define XB_SPIN_CAP (1u << 18)

__device__ __forceinline__ unsigned xb_ld(unsigned* p)              { return __hip_atomic_load(p, __ATOMIC_RELAXED, __HIP_MEMORY_SCOPE_AGENT); }
__device__ __forceinline__ unsigned xb_add(unsigned* p, unsigned v) { return __hip_atomic_fetch_add(p, v, __ATOMIC_RELAXED, __HIP_MEMORY_SCOPE_AGENT); }
__device__ __forceinline__ unsigned xb_xcc_id() { return (unsigned)__builtin_amdgcn_s_getreg((3 << 11) | 20) & 0xFu; }
#define XB_SPIN(cond, bar) do { unsigned _sp = 0; while (cond) { __builtin_amdgcn_s_sleep(1); \
    if ((++_sp & 255u) == 0u) { if (xb_ld(&(bar)[XB_TMO])) break; if (_sp > XB_SPIN_CAP) { atomicAdd(&(bar)[XB_TMO], 1u); break; } } } } while (0)

struct XcdBarrier {
    unsigned* bar; unsigned x;
    volatile LAS unsigned* st;
};

__device__ __forceinline__ XcdBarrier xcd_barrier_post(unsigned* bar, volatile LAS unsigned* st) {
    XcdBarrier b; b.bar = bar; b.x = xb_xcc_id(); b.st = st;
    if (threadIdx.x == 0) (void)xb_add(&bar[XB_XCNT(b.x)], 1u);
    return b;
}
__device__ __forceinline__ void xcd_barrier_complete(unsigned* bar, unsigned x, unsigned& nloc, unsigned& nx) {
    const unsigned G = gridDim.x * gridDim.y * gridDim.z;
    unsigned sum, cnt, mine, sp = 0u;
    for (;;) {
        sum = 0u; cnt = 0u; mine = 0u;
#pragma unroll
        for (unsigned j = 0; j < 16; ++j) { const unsigned c = xb_ld(&bar[XB_XCNT(j)]); sum += c; cnt += (c > 0u) ? 1u : 0u; mine = (j == x) ? c : mine; }
        if (sum == G) break;
        __builtin_amdgcn_s_sleep(1);
        if ((++sp & 255u) == 0u) { if (xb_ld(&bar[XB_TMO])) break; if (sp > XB_SPIN_CAP) { atomicAdd(&bar[XB_TMO], 1u); break; } }
    }
    nloc = mine > 0u ? mine : 1u; nx = cnt > 0u ? cnt : 1u;
}

__device__ __forceinline__ void xcd_barrier(const XcdBarrier& b) {
    asm volatile("s_waitcnt vmcnt(0)" ::: "memory");
    __syncthreads();
    if (threadIdx.x == 0) {
        unsigned* bar = b.bar;
        __builtin_amdgcn_s_waitcnt(0);
        unsigned nloc = b.st[0], nx = b.st[1];
        if (nloc == 0u) { xcd_barrier_complete(bar, b.x, nloc, nx); b.st[0] = nloc; b.st[1] = nx; }
        const unsigned old = xb_add(&bar[XB_XSUB(b.x)], 1u);
        const unsigned gen = old / nloc;
        if (old + 1u == (gen + 1u) * nloc) {
            __builtin_amdgcn_fence(__ATOMIC_RELEASE, "agent");
            asm volatile("s_waitcnt vmcnt(0)" ::: "memory");
            const unsigned og = xb_add(&bar[XB_TOP], 1u);
            const unsigned tg = og / nx;
            if (og + 1u == (tg + 1u) * nx) xb_add(&bar[XB_TOPGEN], 1u);
            else XB_SPIN(xb_ld(&bar[XB_TOPGEN]) == tg, bar);
            __builtin_amdgcn_fence(__ATOMIC_ACQUIRE, "agent");
            xb_add(&bar[XB_XGEN(b.x)], 1u);
            asm volatile("s_waitcnt vmcnt(0)" ::: "memory");
        } else {
            XB_SPIN(xb_ld(&bar[XB_XGEN(b.x)]) == gen, bar);
            __builtin_amdgcn_fence(__ATOMIC_ACQUIRE, "agent");
            asm volatile("s_waitcnt vmcnt(0)" ::: "memory");
        }
    }
    __syncthreads();
}


struct Args {
    const float* in[19];
    float* out; unsigned char* ws;
};

__device__ __forceinline__ void tr_item(const float* W, int ldw, int k0, int n0, const float* kscale, bf16_t* WT, int ldt, int drow0, int dk0, LAS float* scr, int lane) {
    float wv[32];
#pragma unroll
    for (int i = 0; i < 32; ++i) wv[i] = W[(size_t)(k0 + 2 * i + (lane >> 5)) * ldw + n0 + (lane & 31)];
    if (kscale) {
#pragma unroll
        for (int i = 0; i < 32; ++i) wv[i] *= kscale[k0 + 2 * i + (lane >> 5)]; }
#pragma unroll
    for (int i = 0; i < 32; ++i) scr[(2 * i + (lane >> 5)) * 33 + (lane & 31)] = wv[i];
    LDS_WAIT(); asm volatile("" ::: "memory");
    const int c = lane & 7;
#pragma unroll
    for (int j = 0; j < 4; ++j) { const int n = (lane >> 3) + 8 * j; const LAS float* s = scr + (8 * c) * 33 + n;
        u32x4 o; o.x = cvtpk(s[0 * 33], s[1 * 33]); o.y = cvtpk(s[2 * 33], s[3 * 33]); o.z = cvtpk(s[4 * 33], s[5 * 33]); o.w = cvtpk(s[6 * 33], s[7 * 33]);
        *(u32x4*)(WT + (size_t)(drow0 + n) * ldt + dk0 + 8 * c) = o; }
    LDS_WAIT(); asm volatile("" ::: "memory");
}

__device__ __forceinline__ void convert_weights(const __attribute__((address_space(4))) Args* a, int l, bf16_t* Wb, LAS unsigned char* lds, int gw, int NGW, int wave, int lane, int part) {
    LAS float* scr = (LAS float*)(lds + wave * 8704);
    const float* gu1 = a->in[2] + (size_t)l * DM * 2 * DFF; const float* d1 = a->in[3] + (size_t)l * DFF * DM;
    const float* win = a->in[5] + (size_t)l * DM * DIN; const float* qln = a->in[6] + (size_t)l * QL; const float* kvln = a->in[7] + (size_t)l * KVL;
    const float* wuq = a->in[8] + (size_t)l * QL * 768; const float* wuk = a->in[9] + (size_t)l * KVL * 512; const float* wuv = a->in[10] + (size_t)l * KVL * 512;
    const float* wpool = a->in[13] + (size_t)l * 4 * 128 * 128; const float* wout = a->in[15] + (size_t)l * DM * DM;
    const float* n1 = a->in[1] + (size_t)l * DM; const float* n2 = a->in[4] + (size_t)l * DM; const float* n3 = a->in[16] + (size_t)l * DM;
    const float* gu2 = a->in[17] + (size_t)l * DM * 2 * DFF; const float* d2 = a->in[18] + (size_t)l * DFF * DM;
    constexpr int I_GU = 16 * 176, I_D = 44 * 32, I_IN = 16 * 37, I_UQ = 6 * 24, I_UK = 4 * 16, I_P = 32, I_O = 16 * 32;
    constexpr int NIT = 2 * I_GU + 2 * I_D + I_IN + I_UQ + 2 * I_UK + I_P + I_O;
    const int it_lo = part == 1 ? NIT / 2 : 0, it_hi = part == 0 ? NIT / 2 : NIT;
    for (int it = it_lo + gw; it < it_hi; it += NGW) {
        int r = it;
        if (r < 2 * I_GU) { const int second = r >= I_GU; if (second) r -= I_GU; const int kb = r / 176, nb = r % 176; const int n0 = nb * 32;
            const int j = n0 < DFF ? n0 : n0 - DFF; const int drow = 256 * (j >> 7) + (n0 < DFF ? 0 : 128) + (j & 127);
            tr_item(second ? gu2 : gu1, 2 * DFF, kb * 64, n0, second ? n3 : n1, Wb + (second ? O_WGU2 : O_WGU1), DM, drow, kb * 64, scr, lane); continue; }
        r -= 2 * I_GU;
        if (r < 2 * I_D) { const int second = r >= I_D; if (second) r -= I_D; const int kb = r / 32, nb = r % 32;
            tr_item(second ? d2 : d1, DM, kb * 64, nb * 32, nullptr, Wb + (second ? O_WD2 : O_WD1), DFF, nb * 32, kb * 64, scr, lane); continue; }
        r -= 2 * I_D;
        if (r < I_IN) { const int kb = r / 37, nb = r % 37; tr_item(win, DIN, kb * 64, nb * 32, n2, Wb + O_WIN, DM, nb * 32, kb * 64, scr, lane); continue; }
        r -= I_IN;
        if (r < I_UQ) { const int kb = r / 24, nb = r % 24; tr_item(wuq, 768, kb * 64, nb * 32, qln, Wb + O_WUQ, QL, nb * 32, kb * 64, scr, lane); continue; }
        r -= I_UQ;
        if (r < 2 * I_UK) { const int second = r >= I_UK; if (second) r -= I_UK; const int kb = r / 16, nb = r % 16;
            tr_item(second ? wuv : wuk, 512, kb * 64, nb * 32, kvln, Wb + O_WUKV, KVL, (second ? 512 : 0) + nb * 32, kb * 64, scr, lane); continue; }
        r -= 2 * I_UK;
        if (r < I_P) { const int g = r >> 3, kb = (r >> 2) & 1, nb = r & 3;
            tr_item(wpool + (size_t)g * 128 * 128, 128, kb * 64, nb * 32, nullptr, Wb + O_WPOOL, 512, g * 128 + nb * 32, g * 128 + kb * 64, scr, lane); continue; }
        r -= I_P;
        { const int kb = r / 32, nb = r % 32; tr_item(wout, DM, kb * 64, nb * 32, nullptr, Wb + O_WOUT, DM, nb * 32, kb * 64, scr, lane); }
    }
    if (part == 1) return;
    unsigned zz = 0u; asm volatile("" : "+v"(zz));
    for (int idx = gw * 64 + lane; idx < 512 * 48; idx += NGW * 64) { const int n = idx / 48, kc = idx % 48; const int g = n >> 7; int blk = kc >> 4; blk += (blk >= g) ? 1 : 0;
        *(u32x4*)(Wb + O_WPOOL + (size_t)n * 512 + blk * 128 + (kc & 15) * 8) = (u32x4){zz, zz, zz, zz}; }
}

__device__ __forceinline__ void init_rows(const float* X, bf16_t* XB, u64* SS, float* xcopy, int gw, int NGW, int lane) {
    for (int m = gw; m < SEQ; m += NGW) {
        const f32x4* xr = (const f32x4*)(X + (size_t)m * DM) + lane; f32x4 v[4]; float s = 0.f;
#pragma unroll
        for (int j = 0; j < 4; ++j) { v[j] = xr[64 * j]; s += (v[j].x * v[j].x + v[j].y * v[j].y) + (v[j].z * v[j].z + v[j].w * v[j].w); }
        s = wave_sum(s); if (lane == 0) __hip_atomic_store(SS + m, (u64)(s * SSF), __ATOMIC_RELAXED, __HIP_MEMORY_SCOPE_AGENT);
        u32x2* o = (u32x2*)(XB + (size_t)m * DM) + lane; (void)xcopy;
#pragma unroll
        for (int j = 0; j < 4; ++j) o[64 * j] = (u32x2){cvtpk(v[j].x, v[j].y), cvtpk(v[j].z, v[j].w)};
    }
}
__device__ __forceinline__ void rope_table(float* T, int gtid, int NT) {
    const float inv[16] = {1.0f, 0.5623413324356079f, 0.3162277638912201f, 0.17782793939113617f, 0.10000000149011612f, 0.05623413249850273f, 0.03162277489900589f, 0.017782794311642647f,
                           0.009999999776482582f, 0.005623413249850273f, 0.003162277629598975f, 0.0017782794311642647f, 0.0010000000474974513f, 0.000562341301701963f, 0.0003162277571391314f, 0.00017782794020604342f};
    for (int idx = gtid; idx < SEQ * 16; idx += NT) { const int pos = idx >> 4, i = idx & 15; float iv = inv[0];
#pragma unroll
        for (int q = 1; q < 16; ++q) iv = (i == q) ? inv[q] : iv;
        const float ang = (float)pos * iv; T[pos * 32 + i] = cosf(ang); T[pos * 32 + 16 + i] = sinf(ang); }
}
__device__ __forceinline__ void rowstats_mixed(const bf16_t* ZCp, const float* ZRp, float* RQ, float* RKV, bf16_t* MIX, int gw, int NGW, int lane) {
    const int hsh = lane >> 4, half = 1 << hsh;
    for (int it = gw; it < SEQ / 8; it += NGW) {
        const int m0 = it * 8;
        unsigned q0[8], q1[8], q2[8]; u32x2 kv[8];
#pragma unroll
        for (int j = 0; j < 8; ++j) { const unsigned zo = (unsigned)((m0 + j) * ZC) * 2u; const unsigned* q3 = (const unsigned*)((const char*)ZCp + (zo + 12u * lane)); q0[j] = q3[0]; q1[j] = q3[1]; q2[j] = q3[2];
            kv[j] = *(const u32x2*)((const char*)ZCp + (zo + (unsigned)(QL * 2) + 8u * lane)); }
#pragma unroll
        for (int hf = 0; hf < 2; ++hf) {
            f32x4 P[25]; f32x4 own[8];
            P[0] = (f32x4){0.f, 0.f, 0.f, 0.f};
            const char* zb = (const char*)(ZRp - 8 * ZR); const unsigned off0 = (unsigned)(m0 * ZR + QKR + 8 * lane + 4 * hf) * 4u;
#pragma unroll
            for (int i = 0; i < 24; ++i) P[i + 1] = *(const f32x4*)(zb + (off0 + (unsigned)(i * ZR * 4)));
#pragma unroll
            for (int j = 0; j < 8; ++j) own[j] = P[j + 9];
#pragma unroll
            for (int i = 0; i < 24; ++i) { const int r = m0 - 8 + i; const bool ok = (r >= 0) && (r < SEQ); const f32x4 v = ok ? P[i + 1] : (f32x4){0.f, 0.f, 0.f, 0.f}; P[i + 1] = P[i] + v; }
#pragma unroll
            for (int j = 0; j < 8; ++j) { const int m = m0 + j;
                const f32x4 hiP = hsh == 0 ? P[j + 9] : hsh == 1 ? P[j + 10] : hsh == 2 ? P[j + 12] : P[j + 16];
                const f32x4 loP = hsh == 0 ? P[j + 7] : hsh == 1 ? P[j + 6] : hsh == 2 ? P[j + 4] : P[j];
                const int lo = (m - half) < 0 ? 0 : (m - half), hi = (m + half) > SEQ ? SEQ : (m + half);
                const float ic = 1.f / (float)(hi - lo);
                const f32x4 a = (hiP - loP) * ic - own[j];
                *(u32x2*)(MIX + (size_t)m * PW + 8 * lane + 4 * hf) = (u32x2){cvtpk(a[0], a[1]), cvtpk(a[2], a[3])}; }
        }
#pragma unroll
        for (int j = 0; j < 8; ++j) {
            float sq = bflo(q0[j]) * bflo(q0[j]) + bfhi(q0[j]) * bfhi(q0[j]) + bflo(q1[j]) * bflo(q1[j]) + bfhi(q1[j]) * bfhi(q1[j]) + bflo(q2[j]) * bflo(q2[j]) + bfhi(q2[j]) * bfhi(q2[j]);
            float sk = bflo(kv[j].x) * bflo(kv[j].x) + bfhi(kv[j].x) * bfhi(kv[j].x) + bflo(kv[j].y) * bflo(kv[j].y) + bfhi(kv[j].y) * bfhi(kv[j].y);
            sq = wave_sum(sq); sk = wave_sum(sk);
            if (lane == 0) { RQ[m0 + j] = 1.f / sqrtf(sq * (1.f / QL) + EPS); RKV[m0 + j] = 1.f / sqrtf(sk * (1.f / KVL) + EPS); } }
    }
}
__device__ __forceinline__ void finalize_qkv(const float* QP, const float* KVP, const float* ZRp, const float* RQ, const float* RKV, const float* ROPE,
                                             const float* qn, const float* kn, bf16_t* Qb, bf16_t* Kimg, bf16_t* Vimg, int gw, int NGW, int lane) {
    const int h = lane >> 3, sub = lane & 7;
    f32x4 gq[3], gk[3];
#pragma unroll
    for (int c = 0; c < 3; ++c) { gq[c] = *(const f32x4*)(qn + 32 * c + 4 * sub); gk[c] = *(const f32x4*)(kn + 32 * c + 4 * sub); }
    constexpr int U = 4;
    for (int m0 = gw; m0 < SEQ; m0 += U * NGW) {
        f32x4 cs[U], sn[U], qv[U][3], kv[U][3]; float rq[U], rk[U];
#pragma unroll
        for (int u = 0; u < U; ++u) { const int m = m0 + u * NGW;
            const int mm = m < SEQ ? m : m0;
            cs[u] = *(const f32x4*)(ROPE + (size_t)mm * 32 + 4 * (sub & 3)); sn[u] = *(const f32x4*)(ROPE + (size_t)mm * 32 + 16 + 4 * (sub & 3));
            rq[u] = RQ[mm]; rk[u] = RKV[mm];
#pragma unroll
            for (int c = 0; c < 3; ++c) qv[u][c] = *(const f32x4*)(QP + (size_t)mm * 768 + h * 96 + 32 * c + 4 * sub);
            kv[u][0] = *(const f32x4*)(KVP + (size_t)mm * 1024 + h * 64 + 4 * sub); kv[u][1] = *(const f32x4*)(KVP + (size_t)mm * 1024 + h * 64 + 32 + 4 * sub);
            kv[u][2] = *(const f32x4*)(ZRp + (size_t)mm * ZR + 4 * sub); }
#pragma unroll
        for (int u = 0; u < U; ++u) { const int m = m0 + u * NGW; if (m >= SEQ) break;
            { f32x4 v[3]; float ss = 0.f;
#pragma unroll
              for (int c = 0; c < 3; ++c) { v[c] = qv[u][c] * rq[u]; ss += (v[c].x * v[c].x + v[c].y * v[c].y) + (v[c].z * v[c].z + v[c].w * v[c].w); }
              ss += __shfl_xor(ss, 1); ss += __shfl_xor(ss, 2); ss += __shfl_xor(ss, 4);
              const float rn = 1.f / sqrtf(ss * (1.f / QKH) + EPS);
#pragma unroll
              for (int c = 0; c < 3; ++c) v[c] = v[c] * rn * gq[c];
              f32x4 pt; pt.x = __shfl_xor(v[2].x, 4); pt.y = __shfl_xor(v[2].y, 4); pt.z = __shfl_xor(v[2].z, 4); pt.w = __shfl_xor(v[2].w, 4);
              v[2] = (sub < 4) ? (v[2] * cs[u] - pt * sn[u]) : (v[2] * cs[u] + pt * sn[u]);
#pragma unroll
              for (int c = 0; c < 3; ++c) { const f32x4 y = v[c] * QSCALE; *(u32x2*)(Qb + ((size_t)h * SEQ + m) * QKH + 32 * c + 4 * sub) = (u32x2){cvtpk(y.x, y.y), cvtpk(y.z, y.w)}; } }
            { f32x4 v[3]; float ss = 0.f;
              v[0] = kv[u][0] * rk[u]; v[1] = kv[u][1] * rk[u]; v[2] = kv[u][2];
#pragma unroll
              for (int c = 0; c < 3; ++c) ss += (v[c].x * v[c].x + v[c].y * v[c].y) + (v[c].z * v[c].z + v[c].w * v[c].w);
              ss += __shfl_xor(ss, 1); ss += __shfl_xor(ss, 2); ss += __shfl_xor(ss, 4);
              const float rn = 1.f / sqrtf(ss * (1.f / QKH) + EPS);
#pragma unroll
              for (int c = 0; c < 3; ++c) v[c] = v[c] * rn * gk[c];
              f32x4 pt; pt.x = __shfl_xor(v[2].x, 4); pt.y = __shfl_xor(v[2].y, 4); pt.z = __shfl_xor(v[2].z, 4); pt.w = __shfl_xor(v[2].w, 4);
              v[2] = (sub < 4) ? (v[2] * cs[u] - pt * sn[u]) : (v[2] * cs[u] + pt * sn[u]);
              bf16_t* kt = Kimg + ((size_t)h * 256 + (m >> 6)) * 6144 + (m & 63) * 8 + (sub & 1) * 4;
#pragma unroll
              for (int c = 0; c < 3; ++c) *(u32x2*)(kt + (4 * c + (sub >> 1)) * 512) = (u32x2){cvtpk(v[c].x, v[c].y), cvtpk(v[c].z, v[c].w)}; }
        }
    }
    for (int it = gw; it < (SEQ / 16) * 2; it += NGW) {
        const int g = it >> 1, hh = it & 1; const int tok0 = g * 16; const float rl = RKV[tok0 + (lane & 15)];
#pragma unroll
        for (int h4 = 0; h4 < 4; ++h4) { const int hd = hh * 4 + h4;
#pragma unroll
            for (int hi = 0; hi < 2; ++hi) { float e[8];
#pragma unroll
                for (int j = 0; j < 8; ++j) { const int t = 8 * (j >> 2) + 4 * hi + (j & 3); e[j] = KVP[(size_t)(tok0 + t) * 1024 + 512 + hd * 64 + lane] * __shfl(rl, t); }
                *(u32x4*)(Vimg + ((size_t)hd * 256 + (g >> 2)) * 4096 + ((size_t)((g & 3) * 2 + hi) * 64 + lane) * 8) = (u32x4){cvtpk(e[0], e[1]), cvtpk(e[2], e[3]), cvtpk(e[4], e[5]), cvtpk(e[6], e[7])}; } }
    }
}

constexpr int AT_BUF = 20480;
constexpr float ATT_THR = 8.f;
__device__ __forceinline__ float max3f(float a, float b, float c) { float r; asm("v_max3_f32 %0, %1, %2, %3" : "=v"(r) : "v"(a), "v"(b), "v"(c)); return r; }
__device__ __forceinline__ float max2f(float a, float b) { float r; asm("v_max_f32_e32 %0, %1, %2" : "=v"(r) : "v"(a), "v"(b)); return r; }
__device__ __forceinline__ float halfmax(float m) { auto rr = __builtin_amdgcn_permlane32_swap(__float_as_uint(m), __float_as_uint(m), false, false); return max2f(__uint_as_float(rr[0]), __uint_as_float(rr[1])); }
__device__ __forceinline__ const char* uniform_ptr(const char* p) { const unsigned long long v = (unsigned long long)p; const unsigned lo = __builtin_amdgcn_readfirstlane((unsigned)v), hi = __builtin_amdgcn_readfirstlane((unsigned)(v >> 32)); return (const char*)(((unsigned long long)hi << 32) | lo); }
#define AT_BAR() do { __builtin_amdgcn_sched_barrier(0); asm volatile("s_waitcnt lgkmcnt(0)\n\ts_barrier" ::: "memory"); __builtin_amdgcn_sched_barrier(0); } while (0)
#define AT_VM(N) asm volatile("s_waitcnt vmcnt(" #N ")" ::: "memory")
__device__ __forceinline__ void attn_phase(LAS unsigned char* lds, const bf16_t* Qb, const bf16_t* Kimg, const bf16_t* Vimg, bf16_t* AB, int bid, int G, int wave_k) {
    const int tid = fresh_tid(wave_k);
    const int lane = tid & 63, r32 = lane & 31, hi = lane >> 5; const int wid = __builtin_amdgcn_readfirstlane(tid >> 6);
    const bool grpB = wid >= 4;
    const unsigned lane16 = (unsigned)lane * 16u;
    const unsigned frag = (unsigned)(hi * 1024 + r32 * 16);
    for (int u = bid; u < NH * (SEQ / 512); u += G) {
        const int h = u & 7, qb = u >> 3; const int qrow0 = qb * 512 + wid * 64;
        bf16x8 qr[2][6];
        { int lq = lane; asm volatile("" : "+v"(lq));
          const char* qbase = (const char*)(Qb + ((size_t)h * SEQ + qrow0) * QKH); const unsigned qoff = (unsigned)((lq & 31) * (QKH * 2) + 16 * (lq >> 5));
#pragma unroll
          for (int b = 0; b < 2; ++b)
#pragma unroll
            for (int d0 = 0; d0 < 6; ++d0) qr[b][d0] = *(const bf16x8*)(qbase + qoff + (unsigned)(32 * b * (QKH * 2) + 32 * d0)); }
        const char* Kt = (const char*)(Kimg + (size_t)h * 256 * 6144); const char* Vt = (const char*)(Vimg + (size_t)h * 256 * 4096);
        const char* g0 = Kt + wid * 1024; const char* g1 = (wid < 4) ? Kt + (wid + 8) * 1024 : Vt + (wid - 4) * 1024; const char* g2 = Vt + (wid + 4) * 1024;
        const int l0 = wid * 1024, l1 = (wid < 4) ? (wid + 8) * 1024 : 12288 + (wid - 4) * 1024, l2 = 12288 + (wid + 4) * 1024;
        const size_t s0 = 12288, s1 = (wid < 4) ? 12288 : 8192, s2 = 8192;
#define AT_ISSUE(t, boff) do { \
            __builtin_amdgcn_global_load_lds((const unsigned*)(uniform_ptr(g0 + (size_t)(t) * s0) + lane16), (LAS unsigned*)(lds + (boff) + l0), 16, 0, 0); \
            __builtin_amdgcn_global_load_lds((const unsigned*)(uniform_ptr(g1 + (size_t)(t) * s1) + lane16), (LAS unsigned*)(lds + (boff) + l1), 16, 0, 0); \
            if (wid < 4) __builtin_amdgcn_global_load_lds((const unsigned*)(uniform_ptr(g2 + (size_t)(t) * s2) + lane16), (LAS unsigned*)(lds + (boff) + l2), 16, 0, 0); } while (0)
        float mhat[2] = {0.f, 0.f}, lrun[2] = {0.f, 0.f}; f32x16 o[2][2], negm[2], p[2]; bf16x8 pf[2][2];
#pragma unroll
        for (int b = 0; b < 2; ++b)
#pragma unroll
            for (int r = 0; r < 16; ++r) { o[b][0][r] = 0.f; o[b][1][r] = 0.f; negm[b][r] = 0.f; }
#pragma unroll
        for (int b = 0; b < 2; ++b) for (int s2 = 0; s2 < 2; ++s2) for (int e = 0; e < 8; ++e) pf[b][s2][e] = 0;
#define AT_MSEG(kboff, kb2, vboff, sbase) do { \
            const LAS unsigned char* kbase_ = lds + (kboff) + frag + (kb2) * 512; const LAS unsigned char* vb_ = lds + (vboff) + 12288 + frag + (sbase) * 2048; \
            bf16x8 kf[6], vf[2][2]; \
            _Pragma("unroll") for (int d0 = 0; d0 < 6; ++d0) kf[d0] = *(const LAS bf16x8*)(kbase_ + d0 * 2048); \
            _Pragma("unroll") for (int s2 = 0; s2 < 2; ++s2) { vf[s2][0] = *(const LAS bf16x8*)(vb_ + s2 * 2048); vf[s2][1] = *(const LAS bf16x8*)(vb_ + s2 * 2048 + 512); } \
            __builtin_amdgcn_sched_barrier(0);     \
            _Pragma("unroll") for (int d0 = 0; d0 < 6; ++d0) \
                _Pragma("unroll") for (int b = 0; b < 2; ++b) p[b] = __builtin_amdgcn_mfma_f32_32x32x16_bf16(kf[d0], qr[b][d0], d0 == 0 ? negm[b] : p[b], 0, 0, 0); \
            __builtin_amdgcn_sched_barrier(0);     \
            _Pragma("unroll") for (int s2 = 0; s2 < 2; ++s2) \
                _Pragma("unroll") for (int b = 0; b < 2; ++b) { o[b][0] = __builtin_amdgcn_mfma_f32_32x32x16_bf16(vf[s2][0], pf[b][s2], o[b][0], 0, 0, 0); o[b][1] = __builtin_amdgcn_mfma_f32_32x32x16_bf16(vf[s2][1], pf[b][s2], o[b][1], 0, 0, 0); } } while (0)
#define AT_PV(boff, sbase) do { const LAS unsigned char* vb_ = lds + (boff) + 12288 + frag + (sbase) * 2048; \
            _Pragma("unroll") for (int s2 = 0; s2 < 2; ++s2) { const bf16x8 v0 = *(const LAS bf16x8*)(vb_ + s2 * 2048), v1 = *(const LAS bf16x8*)(vb_ + s2 * 2048 + 512); \
                _Pragma("unroll") for (int b = 0; b < 2; ++b) { o[b][0] = __builtin_amdgcn_mfma_f32_32x32x16_bf16(v0, pf[b][s2], o[b][0], 0, 0, 0); o[b][1] = __builtin_amdgcn_mfma_f32_32x32x16_bf16(v1, pf[b][s2], o[b][1], 0, 0, 0); } } } while (0)
#define AT_SM(FIRST) do { \
            asm volatile("s_nop 3" : "+v"(p[0]), "+v"(p[1]));     \
            float rm[2]; \
            _Pragma("unroll") for (int b = 0; b < 2; ++b) { float a = max3f(p[b][0], p[b][1], p[b][2]), c = max3f(p[b][3], p[b][4], p[b][5]); \
                a = max3f(a, p[b][6], p[b][7]); c = max3f(c, p[b][8], p[b][9]); a = max3f(a, p[b][10], p[b][11]); c = max3f(c, p[b][12], p[b][13]); a = max3f(a, p[b][14], p[b][15]); \
                rm[b] = max2f(a, c); }     \
            if ((FIRST) || __any(__float_as_int(max2f(rm[0], rm[1])) > __float_as_int(ATT_THR))) {     \
                _Pragma("unroll") for (int b = 0; b < 2; ++b) { rm[b] = halfmax(rm[b]); const float dl = (FIRST) ? rm[b] : fmaxf(rm[b], 0.f); mhat[b] += dl; const float f = (FIRST) ? 1.f : __builtin_amdgcn_exp2f(-dl); lrun[b] *= f; \
                    _Pragma("unroll") for (int r = 0; r < 16; ++r) { p[b][r] -= dl; negm[b][r] = -mhat[b]; o[b][0][r] *= f; o[b][1][r] *= f; } } \
            } \
            _Pragma("unroll") for (int b = 0; b < 2; ++b) {     \
                _Pragma("unroll") for (int r = 0; r < 16; ++r) { p[b][r] = __builtin_amdgcn_exp2f(p[b][r]); lrun[b] += p[b][r]; } \
                _Pragma("unroll") for (int s2 = 0; s2 < 2; ++s2) { const f32x16& x = p[b]; const int o8 = 8 * s2; \
                    pf[b][s2] = __builtin_bit_cast(bf16x8, (u32x4){cvtpk(x[o8], x[o8 + 1]), cvtpk(x[o8 + 2], x[o8 + 3]), cvtpk(x[o8 + 4], x[o8 + 5]), cvtpk(x[o8 + 6], x[o8 + 7])}); } } \
            asm volatile("" : "+v"(pf[0][0]), "+v"(pf[0][1]), "+v"(pf[1][0]), "+v"(pf[1][1]), "+v"(lrun[0]), "+v"(lrun[1]));     \
            } while (0)
#define AT_PIN_M() asm volatile("" : "+v"(p[0]), "+v"(p[1]), "+v"(o[0][0]), "+v"(o[0][1]), "+v"(o[1][0]), "+v"(o[1][1]))
        int b_prev = 2 * AT_BUF, b_cur = 0, b_next = AT_BUF;
        AT_ISSUE(0, 0); AT_ISSUE(1, AT_BUF);
        asm volatile("s_waitcnt vmcnt(0)" ::: "memory"); AT_BAR();
        if (grpB) AT_BAR();
        for (int t = 0; t < 256; ++t) {
            AT_MSEG(b_cur, 0, (t > 0 ? b_prev : b_cur), 2);
            AT_PIN_M();
            AT_BAR();
            AT_SM(t == 0);
            AT_BAR();
            const bool issued = (t + 2 < 256);
            if (issued) AT_ISSUE(t + 2, b_prev);
            AT_MSEG(b_cur, 1, b_cur, 0);
            AT_PIN_M();
            if (grpB) { if (issued) AT_VM(2); else AT_VM(0); }
            AT_BAR();
            AT_SM(false);
            if (!grpB) { if (issued) AT_VM(3); else AT_VM(0); }
            AT_BAR();
            const int tmp = b_prev; b_prev = b_cur; b_cur = b_next; b_next = tmp;
        }
        AT_PV(b_prev, 2);
        if (!grpB) AT_BAR();
        AT_BAR();
#undef AT_ISSUE
#undef AT_MSEG
#undef AT_PV
#undef AT_SM
#undef AT_PIN_M
        int lane_o = lane; asm volatile("" : "+v"(lane_o));
#pragma unroll
        for (int b = 0; b < 2; ++b) { const float lt = lrun[b] + __shfl_xor(lrun[b], 32), il = 1.f / lt;
            bf16_t* orow = AB + (size_t)(qrow0 + 32 * b + (lane_o & 31)) * DM + h * VH + 4 * (lane_o >> 5);
#pragma unroll
            for (int g = 0; g < 4; ++g) {
                *(u32x2*)(orow + 8 * g) = (u32x2){cvtpk(o[b][0][4 * g] * il, o[b][0][4 * g + 1] * il), cvtpk(o[b][0][4 * g + 2] * il, o[b][0][4 * g + 3] * il)};
                *(u32x2*)(orow + 32 + 8 * g) = (u32x2){cvtpk(o[b][1][4 * g] * il, o[b][1][4 * g + 1] * il), cvtpk(o[b][1][4 * g + 2] * il, o[b][1][4 * g + 3] * il)}; } }
    }
}

typedef const __attribute__((address_space(4))) Args* KArgs;
__device__ __forceinline__ KArgs fresh_args() { KArgs p = (KArgs)__builtin_amdgcn_kernarg_segment_ptr(); asm volatile("" : "+s"(p)); return p; }
#define PH_BEGIN() KArgs ap = fresh_args(); unsigned char* ws = ap->ws; float* X = ap->out; (void)X; \
    bf16_t* Wb = (bf16_t*)(ws + ((l & 1) ? WS_W2 : WS_W)); bf16_t* Wnext = (bf16_t*)(ws + ((l & 1) ? WS_W : WS_W2)); (void)Wnext; bf16_t* HN = (bf16_t*)(ws + WS_HN); bf16_t* ACT = (bf16_t*)(ws + WS_ACT); \
    float* QP = (float*)(ws + WS_QP); float* KVP = (float*)(ws + WS_KVP); bf16_t* ZCb = (bf16_t*)(ws + WS_ZC); float* ZRb = (float*)(ws + WS_ZR); \
    bf16_t* MIX = (bf16_t*)(ws + WS_MIX); float* RQ = (float*)(ws + WS_RQ); float* RKV = (float*)(ws + WS_RKV); float* ROPE = (float*)(ws + WS_ROPE); u64* SSb = (u64*)(ws + WS_SS); (void)SSb; \
    bf16_t* Qb = (bf16_t*)(ws + WS_Q); bf16_t* Kimg = (bf16_t*)(ws + WS_K); bf16_t* Vimg = (bf16_t*)(ws + WS_V); bf16_t* AB = (bf16_t*)(ws + WS_AB); \
    (void)Wb; (void)HN; (void)ACT; (void)QP; (void)KVP; (void)ZCb; (void)ZRb; (void)MIX; (void)RQ; (void)RKV; (void)ROPE; (void)Qb; (void)Kimg; (void)Vimg; (void)AB; \
    const int tid = fresh_tid(wave_k); int bid = blockIdx.x, G = gridDim.x; asm volatile("" : "+s"(bid), "+s"(G)); const int lane = tid & 63, wave = __builtin_amdgcn_readfirstlane(tid >> 6), NGW = G * 8, gw = bid * 8 + wave; \
    (void)lane; (void)gw; (void)NGW; pg8::StaticOrder S; (void)S

__global__ void __launch_bounds__(512, 2) fwd_kernel(Args a_unused) {
    extern __shared__ __attribute__((aligned(16))) unsigned char lds_raw[];
    LAS unsigned char* lds = (LAS unsigned char*)lds_raw;
    cg::grid_group grid = cg::this_grid();
    const int wave_k = __builtin_amdgcn_readfirstlane((int)(threadIdx.x >> 6));
    volatile LAS unsigned* bst = (volatile LAS unsigned*)(lds + 131072);
    if (threadIdx.x < 2) bst[threadIdx.x] = 0u;
    __syncthreads();
    XcdBarrier xbar; { KArgs ap0 = fresh_args(); xbar = xcd_barrier_post((unsigned*)(ap0->ws + WS_CTL), bst); }
#define GSYNC() xcd_barrier(xbar)
    for (int l = 0; l < DEPTH; ++l) {
        if (l == 0) { PH_BEGIN(); convert_weights(ap, l, Wb, lds, gw, NGW, wave, lane, -1);
          { rope_table(ROPE, bid * 512 + tid, G * 512); init_rows(ap->in[0], HN, SSb, X, gw, NGW, lane);
              for (int i = bid * 512 + tid; i < DEPTH * 3 * SEQ; i += G * 512) __hip_atomic_store(SSb + SEQ + i, (u64)0, __ATOMIC_RELAXED, __HIP_MEMORY_SCOPE_AGENT); } }
        if (l == 0) grid.sync();
        { PH_BEGIN(); pg8::Gemm g{HN, Wb + O_WGU1, SEQ, 2 * DFF, DM, DM}; S.init(SEQ, 2 * DFF, G, bid); pg8::EpiSwiGLU E{ACT, SSb + (size_t)(3 * l) * SEQ}; pg8::gemm_phase(lds, g, S, E, wave_k);
          if (l + 1 < DEPTH && bid >= G / 2) convert_weights(ap, l + 1, Wnext, lds, (bid - G / 2) * 8 + wave, (G - G / 2) * 8, wave, lane, 0); }
        GSYNC();
        { PH_BEGIN(); pg8::Gemm g{ACT, Wb + O_WD1, SEQ, DM, DFF, DFF}; S.init(SEQ, DM, G, bid); pg8::EpiResid E{l == 0 ? ap->in[0] : (const float*)X, X, HN, SSb + (size_t)(3 * l + 1) * SEQ, 0.5f}; pg8::gemm_phase(lds, g, S, E, wave_k); }
        GSYNC();
        { PH_BEGIN(); pg8::Gemm g{HN, Wb + O_WIN, SEQ, DINP, DM, DM}; S.init(SEQ, DINP, G, bid); pg8::EpiZ E{ZCb, ZRb, SSb + (size_t)(3 * l + 1) * SEQ}; pg8::gemm_phase(lds, g, S, E, wave_k); }
        GSYNC();
        { PH_BEGIN(); rowstats_mixed(ZCb, ZRb, RQ, RKV, MIX, gw, NGW, lane); }
        { PH_BEGIN(); pg8::Gemm g{ZCb, Wb + O_WUQ, SEQ, 768, QL, ZC}; S.init(SEQ, 768, G, bid); pg8::EpiF32 E{QP, 768}; pg8::gemm_phase(lds, g, S, E, wave_k); }
        { PH_BEGIN(); pg8::Gemm g{ZCb + QL, Wb + O_WUKV, SEQ, 1024, KVL, ZC}; S.init(SEQ, 1024, G, bid); pg8::EpiF32 E{KVP, 1024}; pg8::gemm_phase(lds, g, S, E, wave_k); }
        GSYNC();
        { PH_BEGIN(); finalize_qkv(QP, KVP, ZRb, RQ, RKV, ROPE, ap->in[11] + (size_t)l * QKH, ap->in[12] + (size_t)l * QKH, Qb, Kimg, Vimg, gw, NGW, lane); }
        { PH_BEGIN(); pg8::Gemm g{MIX, Wb + O_WPOOL, SEQ, PW, PW, PW}; S.init(SEQ, PW, G, bid); pg8::EpiPool E{AB, ap->in[14] + (size_t)l * PW}; pg8::gemm_phase(lds, g, S, E, wave_k); }
        GSYNC();
        { PH_BEGIN(); attn_phase(lds, Qb, Kimg, Vimg, AB, bid, G, wave_k); }
        GSYNC();
        { PH_BEGIN(); pg8::Gemm g{AB, Wb + O_WOUT, SEQ, DM, DM, DM}; S.init(SEQ, DM, G, bid); pg8::EpiResid E{X, X, HN, SSb + (size_t)(3 * l + 2) * SEQ, 1.0f}; pg8::gemm_phase(lds, g, S, E, wave_k); }
        GSYNC();
        { PH_BEGIN(); pg8::Gemm g{HN, Wb + O_WGU2, SEQ, 2 * DFF, DM, DM}; S.init(SEQ, 2 * DFF, G, bid); pg8::EpiSwiGLU E{ACT, SSb + (size_t)(3 * l + 2) * SEQ}; pg8::gemm_phase(lds, g, S, E, wave_k);
          if (l + 1 < DEPTH && bid >= G / 2) convert_weights(ap, l + 1, Wnext, lds, (bid - G / 2) * 8 + wave, (G - G / 2) * 8, wave, lane, 1); }
        GSYNC();
        { PH_BEGIN(); pg8::Gemm g{ACT, Wb + O_WD2, SEQ, DM, DFF, DFF}; S.init(SEQ, DM, G, bid); pg8::EpiResid E{X, X, HN, SSb + (size_t)(3 * l + 3) * SEQ, 0.5f}; pg8::gemm_phase(lds, g, S, E, wave_k); }
        if (l + 1 < DEPTH) GSYNC();
    }
}

extern "C" void kernel_launch(void* const* d_in, const int* in_sizes, int n_in, void* d_out, int out_size, void* d_ws, size_t ws_size, hipStream_t stream) {
    static int grid = 0;
    if (grid == 0) {
        if (n_in != 19 || out_size != SEQ * DM || ws_size < WS_END) { fprintf(stderr, "kernel_launch: unexpected shapes (n_in %d out %d ws %zu need %zu)\n", n_in, out_size, ws_size, (size_t)WS_END); grid = -1; return; }
        int dev = 0, cus = 0, per_cu = 0;
        hipGetDevice(&dev); hipDeviceGetAttribute(&cus, hipDeviceAttributeMultiprocessorCount, dev);
        hipFuncSetAttribute((const void*)fwd_kernel, hipFuncAttributeMaxDynamicSharedMemorySize, LDS_BYTES);
        hipOccupancyMaxActiveBlocksPerMultiprocessor(&per_cu, (const void*)fwd_kernel, 512, LDS_BYTES);
        if (per_cu < 1) { fprintf(stderr, "kernel_launch: occupancy query says %d blocks per CU\n", per_cu); }
        (void)hipGetLastError();
        grid = cus > 0 ? cus : 256;
    }
    if (grid < 0) return;
    if (hipMemsetAsync((char*)d_ws + WS_CTL, 0, CTL_BYTES, stream) != hipSuccess) { fprintf(stderr, "kernel_launch: memset failed\n"); return; }
    Args a{};
    for (int i = 0; i < 19; ++i) a.in[i] = (const float*)d_in[i];
    a.out = (float*)d_out; a.ws = (unsigned char*)d_ws;
    void* args[] = {&a};
    hipError_t e = hipLaunchCooperativeKernel((const void*)fwd_kernel, dim3(grid), dim3(512), args, LDS_BYTES, stream);
    if (e != hipSuccess) fprintf(stderr, "cooperative launch failed: %s (grid %d)\n", hipGetErrorString(e), grid);
}
```

```cpp
#include <hip/hip_runtime.h>
#include <hip/hip_cooperative_groups.h>
#include <cstdio>
#include <cstdint>
namespace cg = cooperative_groups;

#define LAS __attribute__((address_space(3)))
typedef unsigned short bf16_t;
typedef short bf16x8 __attribute__((ext_vector_type(8)));
typedef float f32x4 __attribute__((ext_vector_type(4)));
typedef float f32x16 __attribute__((ext_vector_type(16)));
typedef unsigned u32x4 __attribute__((ext_vector_type(4)));
typedef unsigned u32x2 __attribute__((ext_vector_type(2)));
typedef float f32x2_t __attribute__((ext_vector_type(2)));
typedef __bf16 bf16x2_t __attribute__((ext_vector_type(2)));

constexpr int SEQ = 16384, DM = 1024, DEPTH = 4, NH = 8, QKN = 64, QKR = 32, QKH = 96, VH = 64, QL = 384, KVL = 256;
constexpr int PW = 512, DIN = 1184, DINP = 1280, DFF = 2816, ZC = QL + KVL  , ZR = QKR + PW  ;
constexpr float EPS = 1e-6f;
constexpr float QSCALE = 0.14724444602590306f;

constexpr size_t E_WGU = (size_t)2 * DFF * DM, E_WD = (size_t)DM * DFF, E_WIN = (size_t)DINP * DM, E_WUQ = (size_t)768 * QL, E_WUKV = (size_t)1024 * KVL,
                 E_WPOOL = (size_t)512 * 512, E_WOUT = (size_t)DM * DM;
constexpr size_t O_WGU1 = 0, O_WD1 = O_WGU1 + E_WGU, O_WIN = O_WD1 + E_WD, O_WUQ = O_WIN + E_WIN, O_WUKV = O_WUQ + E_WUQ, O_WPOOL = O_WUKV + E_WUKV,
                 O_WOUT = O_WPOOL + E_WPOOL, O_WGU2 = O_WOUT + E_WOUT, O_WD2 = O_WGU2 + E_WGU, E_WALL = O_WD2 + E_WD;
constexpr size_t al256(size_t x) { return (x + 255) & ~(size_t)255; }
constexpr size_t WS_W = 0;
constexpr size_t WS_W2 = al256(WS_W + E_WALL * 2);
constexpr size_t WS_HN = al256(WS_W2 + E_WALL * 2);
constexpr size_t WS_ACT = WS_HN + (size_t)SEQ * DM * 2;
constexpr size_t WS_QP = WS_HN;
constexpr size_t WS_KVP = WS_QP + (size_t)SEQ * 768 * 4;
constexpr size_t WS_ZC = al256(WS_ACT + (size_t)SEQ * DFF * 2);
constexpr size_t WS_ZR = WS_ZC + (size_t)SEQ * ZC * 2;
constexpr size_t WS_MIX = WS_ZR + (size_t)SEQ * ZR * 4;
constexpr size_t WS_RQ = WS_MIX + (size_t)SEQ * PW * 2;
constexpr size_t WS_RKV = WS_RQ + (size_t)SEQ * 4;
constexpr size_t WS_ROPE = WS_RKV + (size_t)SEQ * 4;
constexpr size_t WS_SS = WS_ROPE + (size_t)SEQ * 32 * 4;
constexpr size_t WS_Q = WS_SS + (size_t)(DEPTH * 3 + 1) * SEQ * 8;
constexpr size_t WS_K = WS_Q + (size_t)NH * SEQ * QKH * 2;
constexpr size_t WS_V = WS_K + (size_t)NH * SEQ * QKH * 2;
constexpr size_t WS_AB = WS_V + (size_t)NH * SEQ * VH * 2;
constexpr size_t WS_CTL = WS_AB + (size_t)SEQ * DM * 2;
constexpr size_t CTL_BYTES = 16384;
constexpr size_t WS_END = WS_CTL + CTL_BYTES;
static_assert(WS_END <= (size_t)390140864, "workspace map exceeds the guaranteed d_ws size (sum of the input bytes)");
static_assert(WS_KVP + (size_t)SEQ * 1024 * 4 <= WS_ZC, "q'/kv' alias inside hn|act");

constexpr int LDS_BYTES = 135168;

__device__ __forceinline__ unsigned cvtpk(float lo, float hi) { f32x2_t v = {lo, hi}; bf16x2_t b = __builtin_convertvector(v, bf16x2_t); return __builtin_bit_cast(unsigned, b); }
__device__ __forceinline__ float bf2f(unsigned short b) { return __builtin_bit_cast(float, (unsigned)b << 16); }
__device__ __forceinline__ float bflo(unsigned w) { return __builtin_bit_cast(float, w << 16); }
__device__ __forceinline__ float bfhi(unsigned w) { return __builtin_bit_cast(float, w & 0xffff0000u); }
__device__ __forceinline__ float wave_sum(float v) {
#pragma unroll
    for (int o = 1; o < 64; o <<= 1) v += __shfl_xor(v, o);
    return v;
}
typedef unsigned long long u64;
constexpr float SSF = 16777216.f, SSFI = 1.f / 16777216.f;
__device__ __forceinline__ float ss_rs(u64 v) { return 1.f / sqrtf((float)v * (SSFI / 1024.f) + 1e-6f); }
__device__ __forceinline__ int fresh_tid(int wave_k) { unsigned ones = ~0u; asm volatile("" : "+s"(ones)); const int l = (int)__builtin_amdgcn_mbcnt_hi(ones, __builtin_amdgcn_mbcnt_lo(ones, 0u)); return wave_k * 64 + l; }
#define LDS_WAIT() asm volatile("s_waitcnt lgkmcnt(0)" ::: "memory")

namespace pg8 {
constexpr int BM = 256, BK = 64, HALF = 128, HTB = HALF * BK * 2, STAGE_BYTES = 8 * HTB, NXCD = 8, WGM = 8;
__device__ __forceinline__ int lds_byte(int r, int c) { const int st = (r >> 4) * 2 + (c >> 5), rr = r & 15, cc = c & 31, ob = rr * 64 + cc * 2; return st * 1024 + (ob ^ (((ob >> 9) & 1) << 5)); }
__device__ __forceinline__ void stage_rc(int b, int& R, int& C) { const int st = b / 1024, sb = b % 1024, swz = sb ^ (((sb >> 9) & 1) << 5); R = (st >> 1) * 16 + swz / 64; C = (st & 1) * 32 + (swz % 64) / 2; }
__device__ __forceinline__ int perm32(int rho) { const int n = rho >> 4, i = rho & 15; return 8 * (i >> 2) + 4 * n + (i & 3); }
struct Unit { int pm, pn; };
struct Gemm { const bf16_t* A; const bf16_t* Bt; int M, N, K, lda; };
struct StaticOrder {
    int nM, nN, nwg, G, c;
    __device__ void init(int M, int N, int G_, int c_) { nM = M / BM; nN = N / BM; nwg = nM * nN; G = G_; c = c_; }
    __device__ bool next(int i, Unit& u) const {
        const long L = (long)i * G + c; if (L >= nwg) return false;
        int wgid = (int)L; { const int q = nwg / NXCD, r = nwg % NXCD, xcd = wgid % NXCD, off = wgid / NXCD; wgid = (xcd < r ? xcd * (q + 1) : r * (q + 1) + (xcd - r) * q) + off; }
        const int nig = WGM * nN, gid = wgid / nig, fm = gid * WGM, gsz = (nM - fm) < WGM ? (nM - fm) : WGM;
        u.pm = fm + ((wgid % nig) % gsz); u.pn = (wgid % nig) / gsz; return true;
    }
};
template <class Epi, bool ALIGN_EPI = true>
__device__ __forceinline__ void gemm_phase(LAS unsigned char* lds, const Gemm g, const StaticOrder& S, const Epi& E, int wave_k) {
    const int tid = fresh_tid(wave_k);
    const int wid = __builtin_amdgcn_readfirstlane(tid >> 6), lane = tid & 63, wr = wid >> 2, wc = wid & 3, fr = lane & 15, fq = lane >> 4;
    const int K = g.K, nt = K / BK, lda = g.lda;
    unsigned voffA[2], voffB[2];
#pragma unroll
    for (int i = 0; i < 2; ++i) { int R, C; stage_rc(tid * 16 + i * 8192, R, C); const int Rb = (R & ~31) + perm32(R & 31);
        voffA[i] = (unsigned)(R * lda + C) * 2u; voffB[i] = (unsigned)(Rb * K + C) * 2u; }
    const size_t kstep = (size_t)(BK * 2);
    const size_t hstepA = (size_t)HALF * lda * 2, hstepB = (size_t)HALF * K * 2;
    const size_t tstepA = 2 * hstepA, tstepB = 2 * hstepB;
    const unsigned ldsw = (unsigned)wid * 1024u;
    const int aoff = lds_byte(wr * 64 + fr, fq * 8), boff = lds_byte(wc * 32 + fr, fq * 8);
#define PG8_SA(b, h) (((b) * 2 + (h)) * HTB)
#define PG8_SB(b, h) ((4 + (b) * 2 + (h)) * HTB)
#define PG8_STAGE(bufoff, gbase, voff) do { _Pragma("unroll") for (int _i = 0; _i < 2; ++_i) \
        __builtin_amdgcn_global_load_lds((const unsigned*)((const char*)(gbase) + (voff)[_i]), (LAS unsigned*)(lds + (bufoff) + ldsw + _i * 8192), 16, 0, 0); } while (0)
#define PG8_LDA(dst, b, h) do { _Pragma("unroll") for (int m = 0; m < 4; ++m) _Pragma("unroll") for (int k = 0; k < 2; ++k) dst[m][k] = *(const LAS bf16x8*)(lds + PG8_SA(b, h) + aoff + m * 2048 + k * 1024); } while (0)
#define PG8_LDB(dst, b, h) do { _Pragma("unroll") for (int n = 0; n < 2; ++n) _Pragma("unroll") for (int k = 0; k < 2; ++k) dst[n][k] = *(const LAS bf16x8*)(lds + PG8_SB(b, h) + boff + n * 2048 + k * 1024); } while (0)
#define PG8_MMA(ai, bj, At, Bt) do { __builtin_amdgcn_s_setprio(1); _Pragma("unroll") for (int m = 0; m < 4; ++m) _Pragma("unroll") for (int n = 0; n < 2; ++n) _Pragma("unroll") for (int k = 0; k < 2; ++k) \
        acc[ai][bj][m][n] = __builtin_amdgcn_mfma_f32_16x16x32_bf16(Bt[n][k], At[m][k], acc[ai][bj][m][n], 0, 0, 0); __builtin_amdgcn_s_setprio(0); } while (0)
#define PG8_WAIT_V(n) asm volatile("s_waitcnt vmcnt(" #n ")" ::: "memory")
#define PG8_WAIT_L(n) asm volatile("s_waitcnt lgkmcnt(" #n ")" ::: "memory")
#define PG8_BAR __builtin_amdgcn_s_barrier()
#define PG8_SCHED __builtin_amdgcn_sched_barrier(0)
    Unit cur, nxt; int ui = 0;
    if (!S.next(0, cur)) return;
    f32x4 acc[2][2][4][2];
#pragma unroll
    for (int a = 0; a < 2; ++a)
#pragma unroll
        for (int b = 0; b < 2; ++b)
#pragma unroll
            for (int m = 0; m < 4; ++m)
#pragma unroll
                for (int n = 0; n < 2; ++n) acc[a][b][m][n] = (f32x4){0.f, 0.f, 0.f, 0.f};
    bf16x8 At[4][2], B0[2][2], B1[2][2];
    const char* cA = (const char*)g.A + (size_t)cur.pm * tstepA; const char* cB = (const char*)g.Bt + (size_t)cur.pn * tstepB;
    PG8_STAGE(PG8_SB(0, 0), cB, voffB); PG8_STAGE(PG8_SB(0, 1), cB + hstepB, voffB); PG8_STAGE(PG8_SA(0, 0), cA, voffA); PG8_STAGE(PG8_SA(0, 1), cA + hstepA, voffA);
    if (wr == 1) PG8_BAR;
    PG8_WAIT_V(2); PG8_BAR;
    PG8_STAGE(PG8_SB(1, 0), cB + kstep, voffB); PG8_STAGE(PG8_SA(1, 0), cA + kstep, voffA); PG8_STAGE(PG8_SB(1, 1), cB + hstepB + kstep, voffB);
    PG8_WAIT_V(6); PG8_BAR;
    for (;;) {
        const bool has_next = S.next(ui + 1, nxt);
        const char* nA = has_next ? (const char*)g.A + (size_t)nxt.pm * tstepA : cA; const char* nB = has_next ? (const char*)g.Bt + (size_t)nxt.pn * tstepB : cB;
        for (int t = 0; t < nt; t += 2) {
            const bool last = (t == nt - 2);
            const char* a1 = cA + (size_t)(t + 1) * kstep;
            const char* a2 = last ? nA : cA + (size_t)(t + 2) * kstep; const char* b2 = last ? nB : cB + (size_t)(t + 2) * kstep;
            const char* a3 = a2 + kstep; const char* b3 = b2 + kstep;
            PG8_LDB(B0, 0, 0); PG8_LDB(B1, 0, 1); PG8_SCHED; PG8_LDA(At, 0, 0); PG8_STAGE(PG8_SA(1, 1), a1 + hstepA, voffA);
            PG8_WAIT_V(8); PG8_WAIT_L(0); PG8_BAR; PG8_MMA(0, 0, At, B0); PG8_MMA(0, 1, At, B1); PG8_BAR; PG8_SCHED;
            PG8_LDA(At, 0, 1); PG8_STAGE(PG8_SB(0, 0), b2, voffB); PG8_STAGE(PG8_SB(0, 1), b2 + hstepB, voffB); PG8_STAGE(PG8_SA(0, 0), a2, voffA);
            PG8_WAIT_V(8); PG8_WAIT_L(0); PG8_BAR; PG8_MMA(1, 0, At, B0); PG8_MMA(1, 1, At, B1); PG8_BAR; PG8_SCHED;
            PG8_LDB(B0, 1, 0); PG8_LDB(B1, 1, 1); PG8_SCHED; PG8_LDA(At, 1, 0); PG8_STAGE(PG8_SA(0, 1), a2 + hstepA, voffA);
            PG8_WAIT_V(8); PG8_WAIT_L(0); PG8_BAR; PG8_MMA(0, 0, At, B0); PG8_MMA(0, 1, At, B1); PG8_BAR; PG8_SCHED;
            PG8_LDA(At, 1, 1); PG8_STAGE(PG8_SB(1, 0), b3, voffB); PG8_STAGE(PG8_SB(1, 1), b3 + hstepB, voffB); PG8_STAGE(PG8_SA(1, 0), a3, voffA);
            PG8_WAIT_V(8); PG8_WAIT_L(0); PG8_BAR; PG8_MMA(1, 0, At, B0); PG8_MMA(1, 1, At, B1); PG8_BAR; PG8_SCHED;
        }
        if constexpr (ALIGN_EPI) { if (wr == 0) PG8_BAR; }
        E(acc, cur, wr, wc, fr, fq);
        if (!has_next) break;
#pragma unroll
        for (int a = 0; a < 2; ++a)
#pragma unroll
            for (int b = 0; b < 2; ++b)
#pragma unroll
                for (int m = 0; m < 4; ++m)
#pragma unroll
                    for (int n = 0; n < 2; ++n) acc[a][b][m][n] = (f32x4){0.f, 0.f, 0.f, 0.f};
        cur = nxt; cA = nA; cB = nB; ++ui;
        if constexpr (ALIGN_EPI) { if (wr == 1) PG8_BAR; }
    }
    PG8_WAIT_V(0);
    if constexpr (!ALIGN_EPI) { if (wr == 0) PG8_BAR; }
    PG8_BAR;
#undef PG8_SA
#undef PG8_SB
#undef PG8_STAGE
#undef PG8_LDA
#undef PG8_LDB
#undef PG8_MMA
#undef PG8_WAIT_V
#undef PG8_WAIT_L
#undef PG8_BAR
#undef PG8_SCHED
}

typedef f32x4 Acc[2][2][4][2];
struct EpiSwiGLU {
    bf16_t* O; const u64* SS;
    __device__ __forceinline__ void operator()(const Acc& acc, const Unit& u, int wr, int wc, int fr, int fq) const {
        const int row0 = u.pm * BM + wr * 64 + fr, col0 = u.pn * 128 + wc * 32 + 8 * fq;
        u64 sv[2][4];
#pragma unroll
        for (int ai = 0; ai < 2; ++ai)
#pragma unroll
            for (int m = 0; m < 4; ++m) sv[ai][m] = SS[row0 + ai * HALF + m * 16];
#pragma unroll
        for (int ai = 0; ai < 2; ++ai)
#pragma unroll
            for (int m = 0; m < 4; ++m) {
                const int row = row0 + ai * HALF + m * 16; const float rs = ss_rs(sv[ai][m]);
                unsigned w[4];
#pragma unroll
                for (int n = 0; n < 2; ++n) {
                    const f32x4 gv = acc[ai][0][m][n] * rs, uv = acc[ai][1][m][n] * rs; float h[4];
#pragma unroll
                    for (int e = 0; e < 4; ++e) { const float gg = gv[e]; h[e] = gg * __builtin_amdgcn_rcpf(1.f + __builtin_amdgcn_exp2f(-1.4426950408889634f * gg)) * uv[e]; }
                    w[2 * n] = cvtpk(h[0], h[1]); w[2 * n + 1] = cvtpk(h[2], h[3]);
                }
                *(u32x4*)(O + (size_t)row * DFF + col0) = (u32x4){w[0], w[1], w[2], w[3]};
            }
    }
};
struct EpiResid {
    const float* Xin; float* X; bf16_t* XB; u64* SS; float scale;
    __device__ __forceinline__ void operator()(const Acc& acc, const Unit& u, int wr, int wc, int fr, int fq) const {
        const int row0 = u.pm * BM + wr * 64 + fr, col0 = u.pn * BM + wc * 32 + 8 * fq;
#pragma unroll
        for (int ai = 0; ai < 2; ++ai)
#pragma unroll
            for (int m = 0; m < 4; ++m) { const int row = row0 + ai * HALF + m * 16; float* rp = X + (size_t)row * DM + col0; const float* ip = Xin + (size_t)row * DM + col0; bf16_t* bp = XB + (size_t)row * DM + col0; float part = 0.f;
#pragma unroll
                for (int bj = 0; bj < 2; ++bj) { f32x4* p = (f32x4*)(rp + bj * HALF); const f32x4* q = (const f32x4*)(ip + bj * HALF); f32x4 a = q[0], b = q[1]; a += acc[ai][bj][m][0] * scale; b += acc[ai][bj][m][1] * scale; p[0] = a; p[1] = b;
                    *(u32x4*)(bp + bj * HALF) = (u32x4){cvtpk(a[0], a[1]), cvtpk(a[2], a[3]), cvtpk(b[0], b[1]), cvtpk(b[2], b[3])};
                    part += (a[0] * a[0] + a[1] * a[1]) + (a[2] * a[2] + a[3] * a[3]) + (b[0] * b[0] + b[1] * b[1]) + (b[2] * b[2] + b[3] * b[3]); }
                part += __shfl_xor(part, 16); part += __shfl_xor(part, 32);
                if (fq == 0) __hip_atomic_fetch_add(SS + row, (u64)(part * SSF), __ATOMIC_RELAXED, __HIP_MEMORY_SCOPE_AGENT); }
    }
};
struct EpiZ {
    bf16_t* ZCp; float* ZRp; const u64* SS;
    __device__ __forceinline__ void operator()(const Acc& acc, const Unit& u, int wr, int wc, int fr, int fq) const {
        const int row0 = u.pm * BM + wr * 64 + fr, col0 = u.pn * BM + wc * 32 + 8 * fq;
        u64 sv[2][4];
#pragma unroll
        for (int ai = 0; ai < 2; ++ai)
#pragma unroll
            for (int m = 0; m < 4; ++m) sv[ai][m] = SS[row0 + ai * HALF + m * 16];
#pragma unroll
        for (int ai = 0; ai < 2; ++ai)
#pragma unroll
            for (int m = 0; m < 4; ++m) { const size_t row = (size_t)(row0 + ai * HALF + m * 16); const float rs = ss_rs(sv[ai][m]);
#pragma unroll
                for (int bj = 0; bj < 2; ++bj) { const int col = col0 + bj * HALF; const f32x4 a = acc[ai][bj][m][0] * rs, b = acc[ai][bj][m][1] * rs;
                    if (col < ZC) *(u32x4*)(ZCp + row * ZC + col) = (u32x4){cvtpk(a[0], a[1]), cvtpk(a[2], a[3]), cvtpk(b[0], b[1]), cvtpk(b[2], b[3])};
                    else if (col < DIN) { f32x4* p = (f32x4*)(ZRp + row * ZR + (col - ZC)); p[0] = a; p[1] = b; } } }
    }
};
struct EpiF32 {
    float* C; int ldc;
    __device__ __forceinline__ void operator()(const Acc& acc, const Unit& u, int wr, int wc, int fr, int fq) const {
        const int row0 = u.pm * BM + wr * 64 + fr, col0 = u.pn * BM + wc * 32 + 8 * fq;
#pragma unroll
        for (int ai = 0; ai < 2; ++ai)
#pragma unroll
            for (int m = 0; m < 4; ++m) { float* rp = C + (size_t)(row0 + ai * HALF + m * 16) * ldc + col0;
#pragma unroll
                for (int bj = 0; bj < 2; ++bj) { f32x4* p = (f32x4*)(rp + bj * HALF); p[0] = acc[ai][bj][m][0]; p[1] = acc[ai][bj][m][1]; } }
    }
};
struct EpiB16 {
    bf16_t* C; int ldc;
    __device__ __forceinline__ void operator()(const Acc& acc, const Unit& u, int wr, int wc, int fr, int fq) const {
        const int row0 = u.pm * BM + wr * 64 + fr, col0 = u.pn * BM + wc * 32 + 8 * fq;
#pragma unroll
        for (int ai = 0; ai < 2; ++ai)
#pragma unroll
            for (int m = 0; m < 4; ++m) { bf16_t* rp = C + (size_t)(row0 + ai * HALF + m * 16) * ldc + col0;
#pragma unroll
                for (int bj = 0; bj < 2; ++bj) { const f32x4 a = acc[ai][bj][m][0], b = acc[ai][bj][m][1];
                    *(u32x4*)(rp + bj * HALF) = (u32x4){cvtpk(a[0], a[1]), cvtpk(a[2], a[3]), cvtpk(b[0], b[1]), cvtpk(b[2], b[3])}; } }
    }
};
struct EpiPool {
    bf16_t* AB; const float* scale;
    __device__ __forceinline__ void operator()(const Acc& acc, const Unit& u, int wr, int wc, int fr, int fq) const {
        const int row0 = u.pm * BM + wr * 64 + fr, col0 = u.pn * BM + wc * 32 + 8 * fq;
#pragma unroll
        for (int ai = 0; ai < 2; ++ai)
#pragma unroll
            for (int m = 0; m < 4; ++m) { const size_t row = (size_t)(row0 + ai * HALF + m * 16);
#pragma unroll
                for (int bj = 0; bj < 2; ++bj) { const int col = col0 + bj * HALF; const f32x4 s0 = *(const f32x4*)(scale + col), s1 = *(const f32x4*)(scale + col + 4);
                    const f32x4 a = acc[ai][bj][m][0] * s0, b = acc[ai][bj][m][1] * s1;
                    *(u32x4*)(AB + row * DM + PW + col) = (u32x4){cvtpk(a[0], a[1]), cvtpk(a[2], a[3]), cvtpk(b[0], b[1]), cvtpk(b[2], b[3])}; } }
    }
};
}

#define XB_TMO      128
#define XB_XCNT(j)  (256  + 64 * (j))
#define XB_XSUB(j)  (1280 + 64 * (j))
#define XB_XGEN(j)  (2304 + 64 * (j))
#define XB_TOP      3328
#define XB_TOPGEN   3392
#define XCD_BAR_WORDS 3456
#define XB_SPIN_CAP (1u << 18)

__device__ __forceinline__ unsigned xb_ld(unsigned* p)              { return __hip_atomic_load(p, __ATOMIC_RELAXED, __HIP_MEMORY_SCOPE_AGENT); }
__device__ __forceinline__ unsigned xb_add(unsigned* p, unsigned v) { return __hip_atomic_fetch_add(p, v, __ATOMIC_RELAXED, __HIP_MEMORY_SCOPE_AGENT); }
__device__ __forceinline__ unsigned xb_xcc_id() { return (unsigned)__builtin_amdgcn_s_getreg((3 << 11) | 20) & 0xFu; }
#define XB_SPIN(cond, bar) do { unsigned _sp = 0; while (cond) { __builtin_amdgcn_s_sleep(1); \
    if ((++_sp & 255u) == 0u) { if (xb_ld(&(bar)[XB_TMO])) break; if (_sp > XB_SPIN_CAP) { atomicAdd(&(bar)[XB_TMO], 1u); break; } } } } while (0)

struct XcdBarrier {
    unsigned* bar; unsigned x;
    volatile LAS unsigned* st;
};

__device__ __forceinline__ XcdBarrier xcd_barrier_post(unsigned* bar, volatile LAS unsigned* st) {
    XcdBarrier b; b.bar = bar; b.x = xb_xcc_id(); b.st = st;
    if (threadIdx.x == 0) (void)xb_add(&bar[XB_XCNT(b.x)], 1u);
    return b;
}
__device__ __forceinline__ void xcd_barrier_complete(unsigned* bar, unsigned x, unsigned& nloc, unsigned& nx) {
    const unsigned G = gridDim.x * gridDim.y * gridDim.z;
    unsigned sum, cnt, mine, sp = 0u;
    for (;;) {
        sum = 0u; cnt = 0u; mine = 0u;
#pragma unroll
        for (unsigned j = 0; j < 16; ++j) { const unsigned c = xb_ld(&bar[XB_XCNT(j)]); sum += c; cnt += (c > 0u) ? 1u : 0u; mine = (j == x) ? c : mine; }
        if (sum == G) break;
        __builtin_amdgcn_s_sleep(1);
        if ((++sp & 255u) == 0u) { if (xb_ld(&bar[XB_TMO])) break; if (sp > XB_SPIN_CAP) { atomicAdd(&bar[XB_TMO], 1u); break; } }
    }
    nloc = mine > 0u ? mine : 1u; nx = cnt > 0u ? cnt : 1u;
}

__device__ __forceinline__ void xcd_barrier(const XcdBarrier& b) {
    asm volatile("s_waitcnt vmcnt(0)" ::: "memory");
    __syncthreads();
    if (threadIdx.x == 0) {
        unsigned* bar = b.bar;
        __builtin_amdgcn_s_waitcnt(0);
        unsigned nloc = b.st[0], nx = b.st[1];
        if (nloc == 0u) { xcd_barrier_complete(bar, b.x, nloc, nx); b.st[0] = nloc; b.st[1] = nx; }
        const unsigned old = xb_add(&bar[XB_XSUB(b.x)], 1u);
        const unsigned gen = old / nloc;
        if (old + 1u == (gen + 1u) * nloc) {
            __builtin_amdgcn_fence(__ATOMIC_RELEASE, "agent");
            asm volatile("s_waitcnt vmcnt(0)" ::: "memory");
            const unsigned og = xb_add(&bar[XB_TOP], 1u);
            const unsigned tg = og / nx;
            if (og + 1u == (tg + 1u) * nx) xb_add(&bar[XB_TOPGEN], 1u);
            else XB_SPIN(xb_ld(&bar[XB_TOPGEN]) == tg, bar);
            __builtin_amdgcn_fence(__ATOMIC_ACQUIRE, "agent");
            xb_add(&bar[XB_XGEN(b.x)], 1u);
            asm volatile("s_waitcnt vmcnt(0)" ::: "memory");
        } else {
            XB_SPIN(xb_ld(&bar[XB_XGEN(b.x)]) == gen, bar);
            __builtin_amdgcn_fence(__ATOMIC_ACQUIRE, "agent");
            asm volatile("s_waitcnt vmcnt(0)" ::: "memory");
        }
    }
    __syncthreads();
}


struct Args {
    const float* in[19];
    float* out; unsigned char* ws;
};

__device__ __forceinline__ void tr_item(const float* W, int ldw, int k0, int n0, const float* kscale, bf16_t* WT, int ldt, int drow0, int dk0, LAS float* scr, int lane) {
    float wv[32];
#pragma unroll
    for (int i = 0; i < 32; ++i) wv[i] = W[(size_t)(k0 + 2 * i + (lane >> 5)) * ldw + n0 + (lane & 31)];
    if (kscale) {
#pragma unroll
        for (int i = 0; i < 32; ++i) wv[i] *= kscale[k0 + 2 * i + (lane >> 5)]; }
#pragma unroll
    for (int i = 0; i < 32; ++i) scr[(2 * i + (lane >> 5)) * 33 + (lane & 31)] = wv[i];
    LDS_WAIT(); asm volatile("" ::: "memory");
    const int c = lane & 7;
#pragma unroll
    for (int j = 0; j < 4; ++j) { const int n = (lane >> 3) + 8 * j; const LAS float* s = scr + (8 * c) * 33 + n;
        u32x4 o; o.x = cvtpk(s[0 * 33], s[1 * 33]); o.y = cvtpk(s[2 * 33], s[3 * 33]); o.z = cvtpk(s[4 * 33], s[5 * 33]); o.w = cvtpk(s[6 * 33], s[7 * 33]);
        *(u32x4*)(WT + (size_t)(drow0 + n) * ldt + dk0 + 8 * c) = o; }
    LDS_WAIT(); asm volatile("" ::: "memory");
}

__device__ __forceinline__ void convert_weights(const __attribute__((address_space(4))) Args* a, int l, bf16_t* Wb, LAS unsigned char* lds, int gw, int NGW, int wave, int lane, int part) {
    LAS float* scr = (LAS float*)(lds + wave * 8704);
    const float* gu1 = a->in[2] + (size_t)l * DM * 2 * DFF; const float* d1 = a->in[3] + (size_t)l * DFF * DM;
    const float* win = a->in[5] + (size_t)l * DM * DIN; const float* qln = a->in[6] + (size_t)l * QL; const float* kvln = a->in[7] + (size_t)l * KVL;
    const float* wuq = a->in[8] + (size_t)l * QL * 768; const float* wuk = a->in[9] + (size_t)l * KVL * 512; const float* wuv = a->in[10] + (size_t)l * KVL * 512;
    const float* wpool = a->in[13] + (size_t)l * 4 * 128 * 128; const float* wout = a->in[15] + (size_t)l * DM * DM;
    const float* n1 = a->in[1] + (size_t)l * DM; const float* n2 = a->in[4] + (size_t)l * DM; const float* n3 = a->in[16] + (size_t)l * DM;
    const float* gu2 = a->in[17] + (size_t)l * DM * 2 * DFF; const float* d2 = a->in[18] + (size_t)l * DFF * DM;
    constexpr int I_GU = 16 * 176, I_D = 44 * 32, I_IN = 16 * 37, I_UQ = 6 * 24, I_UK = 4 * 16, I_P = 32, I_O = 16 * 32;
    constexpr int NIT = 2 * I_GU + 2 * I_D + I_IN + I_UQ + 2 * I_UK + I_P + I_O;
    const int it_lo = part == 1 ? NIT / 2 : 0, it_hi = part == 0 ? NIT / 2 : NIT;
    for (int it = it_lo + gw; it < it_hi; it += NGW) {
        int r = it;
        if (r < 2 * I_GU) { const int second = r >= I_GU; if (second) r -= I_GU; const int kb = r / 176, nb = r % 176; const int n0 = nb * 32;
            const int j = n0 < DFF ? n0 : n0 - DFF; const int drow = 256 * (j >> 7) + (n0 < DFF ? 0 : 128) + (j & 127);
            tr_item(second ? gu2 : gu1, 2 * DFF, kb * 64, n0, second ? n3 : n1, Wb + (second ? O_WGU2 : O_WGU1), DM, drow, kb * 64, scr, lane); continue; }
        r -= 2 * I_GU;
        if (r < 2 * I_D) { const int second = r >= I_D; if (second) r -= I_D; const int kb = r / 32, nb = r % 32;
            tr_item(second ? d2 : d1, DM, kb * 64, nb * 32, nullptr, Wb + (second ? O_WD2 : O_WD1), DFF, nb * 32, kb * 64, scr, lane); continue; }
        r -= 2 * I_D;
        if (r < I_IN) { const int kb = r / 37, nb = r % 37; tr_item(win, DIN, kb * 64, nb * 32, n2, Wb + O_WIN, DM, nb * 32, kb * 64, scr, lane); continue; }
        r -= I_IN;
        if (r < I_UQ) { const int kb = r / 24, nb = r % 24; tr_item(wuq, 768, kb * 64, nb * 32, qln, Wb + O_WUQ, QL, nb * 32, kb * 64, scr, lane); continue; }
        r -= I_UQ;
        if (r < 2 * I_UK) { const int second = r >= I_UK; if (second) r -= I_UK; const int kb = r / 16, nb = r % 16;
            tr_item(second ? wuv : wuk, 512, kb * 64, nb * 32, kvln, Wb + O_WUKV, KVL, (second ? 512 : 0) + nb * 32, kb * 64, scr, lane); continue; }
        r -= 2 * I_UK;
        if (r < I_P) { const int g = r >> 3, kb = (r >> 2) & 1, nb = r & 3;
            tr_item(wpool + (size_t)g * 128 * 128, 128, kb * 64, nb * 32, nullptr, Wb + O_WPOOL, 512, g * 128 + nb * 32, g * 128 + kb * 64, scr, lane); continue; }
        r -= I_P;
        { const int kb = r / 32, nb = r % 32; tr_item(wout, DM, kb * 64, nb * 32, nullptr, Wb + O_WOUT, DM, nb * 32, kb * 64, scr, lane); }
    }
    if (part == 1) return;
    unsigned zz = 0u; asm volatile("" : "+v"(zz));
    for (int idx = gw * 64 + lane; idx < 512 * 48; idx += NGW * 64) { const int n = idx / 48, kc = idx % 48; const int g = n >> 7; int blk = kc >> 4; blk += (blk >= g) ? 1 : 0;
        *(u32x4*)(Wb + O_WPOOL + (size_t)n * 512 + blk * 128 + (kc & 15) * 8) = (u32x4){zz, zz, zz, zz}; }
}

__device__ __forceinline__ void init_rows(const float* X, bf16_t* XB, u64* SS, float* xcopy, int gw, int NGW, int lane) {
    for (int m = gw; m < SEQ; m += NGW) {
        const f32x4* xr = (const f32x4*)(X + (size_t)m * DM) + lane; f32x4 v[4]; float s = 0.f;
#pragma unroll
        for (int j = 0; j < 4; ++j) { v[j] = xr[64 * j]; s += (v[j].x * v[j].x + v[j].y * v[j].y) + (v[j].z * v[j].z + v[j].w * v[j].w); }
        s = wave_sum(s); if (lane == 0) __hip_atomic_store(SS + m, (u64)(s * SSF), __ATOMIC_RELAXED, __HIP_MEMORY_SCOPE_AGENT);
        u32x2* o = (u32x2*)(XB + (size_t)m * DM) + lane; (void)xcopy;
#pragma unroll
        for (int j = 0; j < 4; ++j) o[64 * j] = (u32x2){cvtpk(v[j].x, v[j].y), cvtpk(v[j].z, v[j].w)};
    }
}
__device__ __forceinline__ void rope_table(float* T, int gtid, int NT) {
    const float inv[16] = {1.0f, 0.5623413324356079f, 0.3162277638912201f, 0.17782793939113617f, 0.10000000149011612f, 0.05623413249850273f, 0.03162277489900589f, 0.017782794311642647f,
                           0.009999999776482582f, 0.005623413249850273f, 0.003162277629598975f, 0.0017782794311642647f, 0.0010000000474974513f, 0.000562341301701963f, 0.0003162277571391314f, 0.00017782794020604342f};
    for (int idx = gtid; idx < SEQ * 16; idx += NT) { const int pos = idx >> 4, i = idx & 15; float iv = inv[0];
#pragma unroll
        for (int q = 1; q < 16; ++q) iv = (i == q) ? inv[q] : iv;
        const float ang = (float)pos * iv; T[pos * 32 + i] = cosf(ang); T[pos * 32 + 16 + i] = sinf(ang); }
}
__device__ __forceinline__ void rowstats_mixed(const bf16_t* ZCp, const float* ZRp, float* RQ, float* RKV, bf16_t* MIX, int gw, int NGW, int lane) {
    const int hsh = lane >> 4, half = 1 << hsh;
    for (int it = gw; it < SEQ / 8; it += NGW) {
        const int m0 = it * 8;
        unsigned q0[8], q1[8], q2[8]; u32x2 kv[8];
#pragma unroll
        for (int j = 0; j < 8; ++j) { const unsigned zo = (unsigned)((m0 + j) * ZC) * 2u; const unsigned* q3 = (const unsigned*)((const char*)ZCp + (zo + 12u * lane)); q0[j] = q3[0]; q1[j] = q3[1]; q2[j] = q3[2];
            kv[j] = *(const u32x2*)((const char*)ZCp + (zo + (unsigned)(QL * 2) + 8u * lane)); }
#pragma unroll
        for (int hf = 0; hf < 2; ++hf) {
            f32x4 P[25]; f32x4 own[8];
            P[0] = (f32x4){0.f, 0.f, 0.f, 0.f};
            const char* zb = (const char*)(ZRp - 8 * ZR); const unsigned off0 = (unsigned)(m0 * ZR + QKR + 8 * lane + 4 * hf) * 4u;
#pragma unroll
            for (int i = 0; i < 24; ++i) P[i + 1] = *(const f32x4*)(zb + (off0 + (unsigned)(i * ZR * 4)));
#pragma unroll
            for (int j = 0; j < 8; ++j) own[j] = P[j + 9];
#pragma unroll
            for (int i = 0; i < 24; ++i) { const int r = m0 - 8 + i; const bool ok = (r >= 0) && (r < SEQ); const f32x4 v = ok ? P[i + 1] : (f32x4){0.f, 0.f, 0.f, 0.f}; P[i + 1] = P[i] + v; }
#pragma unroll
            for (int j = 0; j < 8; ++j) { const int m = m0 + j;
                const f32x4 hiP = hsh == 0 ? P[j + 9] : hsh == 1 ? P[j + 10] : hsh == 2 ? P[j + 12] : P[j + 16];
                const f32x4 loP = hsh == 0 ? P[j + 7] : hsh == 1 ? P[j + 6] : hsh == 2 ? P[j + 4] : P[j];
                const int lo = (m - half) < 0 ? 0 : (m - half), hi = (m + half) > SEQ ? SEQ : (m + half);
                const float ic = 1.f / (float)(hi - lo);
                const f32x4 a = (hiP - loP) * ic - own[j];
                *(u32x2*)(MIX + (size_t)m * PW + 8 * lane + 4 * hf) = (u32x2){cvtpk(a[0], a[1]), cvtpk(a[2], a[3])}; }
        }
#pragma unroll
        for (int j = 0; j < 8; ++j) {
            float sq = bflo(q0[j]) * bflo(q0[j]) + bfhi(q0[j]) * bfhi(q0[j]) + bflo(q1[j]) * bflo(q1[j]) + bfhi(q1[j]) * bfhi(q1[j]) + bflo(q2[j]) * bflo(q2[j]) + bfhi(q2[j]) * bfhi(q2[j]);
            float sk = bflo(kv[j].x) * bflo(kv[j].x) + bfhi(kv[j].x) * bfhi(kv[j].x) + bflo(kv[j].y) * bflo(kv[j].y) + bfhi(kv[j].y) * bfhi(kv[j].y);
            sq = wave_sum(sq); sk = wave_sum(sk);
            if (lane == 0) { RQ[m0 + j] = 1.f / sqrtf(sq * (1.f / QL) + EPS); RKV[m0 + j] = 1.f / sqrtf(sk * (1.f / KVL) + EPS); } }
    }
}
__device__ __forceinline__ f32x4 ld4bf(const bf16_t* p) { const u32x2 w = *(const u32x2*)p; return (f32x4){bflo(w.x), bfhi(w.x), bflo(w.y), bfhi(w.y)}; }
__device__ __forceinline__ void finalize_qkv(const bf16_t* QP, const bf16_t* KVP, const float* ZRp, const float* RQ, const float* RKV, const float* ROPE,
                                             const float* qn, const float* kn, bf16_t* Qb, bf16_t* Kimg, bf16_t* Vimg, int gw, int NGW, int lane) {
    const int h = lane >> 3, sub = lane & 7;
    f32x4 gq[3], gk[3];
#pragma unroll
    for (int c = 0; c < 3; ++c) { gq[c] = *(const f32x4*)(qn + 32 * c + 4 * sub); gk[c] = *(const f32x4*)(kn + 32 * c + 4 * sub); }
    constexpr int U = 4;
    for (int m0 = gw; m0 < SEQ; m0 += U * NGW) {
        f32x4 cs[U], sn[U], qv[U][3], kv[U][3]; float rq[U], rk[U];
#pragma unroll
        for (int u = 0; u < U; ++u) { const int m = m0 + u * NGW;
            const int mm = m < SEQ ? m : m0;
            cs[u] = *(const f32x4*)(ROPE + (size_t)mm * 32 + 4 * (sub & 3)); sn[u] = *(const f32x4*)(ROPE + (size_t)mm * 32 + 16 + 4 * (sub & 3));
            rq[u] = RQ[mm]; rk[u] = RKV[mm];
#pragma unroll
            for (int c = 0; c < 3; ++c) qv[u][c] = ld4bf(QP + (size_t)mm * 768 + h * 96 + 32 * c + 4 * sub);
            kv[u][0] = ld4bf(KVP + (size_t)mm * 1024 + h * 64 + 4 * sub); kv[u][1] = ld4bf(KVP + (size_t)mm * 1024 + h * 64 + 32 + 4 * sub);
            kv[u][2] = *(const f32x4*)(ZRp + (size_t)mm * ZR + 4 * sub); }
#pragma unroll
        for (int u = 0; u < U; ++u) { const int m = m0 + u * NGW; if (m >= SEQ) break;
            { f32x4 v[3]; float ss = 0.f;
#pragma unroll
              for (int c = 0; c < 3; ++c) { v[c] = qv[u][c] * rq[u]; ss += (v[c].x * v[c].x + v[c].y * v[c].y) + (v[c].z * v[c].z + v[c].w * v[c].w); }
              ss += __shfl_xor(ss, 1); ss += __shfl_xor(ss, 2); ss += __shfl_xor(ss, 4);
              const float rn = 1.f / sqrtf(ss * (1.f / QKH) + EPS);
#pragma unroll
              for (int c = 0; c < 3; ++c) v[c] = v[c] * rn * gq[c];
              f32x4 pt; pt.x = __shfl_xor(v[2].x, 4); pt.y = __shfl_xor(v[2].y, 4); pt.z = __shfl_xor(v[2].z, 4); pt.w = __shfl_xor(v[2].w, 4);
              v[2] = (sub < 4) ? (v[2] * cs[u] - pt * sn[u]) : (v[2] * cs[u] + pt * sn[u]);
#pragma unroll
              for (int c = 0; c < 3; ++c) { const f32x4 y = v[c] * QSCALE; *(u32x2*)(Qb + ((size_t)h * SEQ + m) * QKH + 32 * c + 4 * sub) = (u32x2){cvtpk(y.x, y.y), cvtpk(y.z, y.w)}; } }
            { f32x4 v[3]; float ss = 0.f;
              v[0] = kv[u][0] * rk[u]; v[1] = kv[u][1] * rk[u]; v[2] = kv[u][2];
#pragma unroll
              for (int c = 0; c < 3; ++c) ss += (v[c].x * v[c].x + v[c].y * v[c].y) + (v[c].z * v[c].z + v[c].w * v[c].w);
              ss += __shfl_xor(ss, 1); ss += __shfl_xor(ss, 2); ss += __shfl_xor(ss, 4);
              const float rn = 1.f / sqrtf(ss * (1.f / QKH) + EPS);
#pragma unroll
              for (int c = 0; c < 3; ++c) v[c] = v[c] * rn * gk[c];
              f32x4 pt; pt.x = __shfl_xor(v[2].x, 4); pt.y = __shfl_xor(v[2].y, 4); pt.z = __shfl_xor(v[2].z, 4); pt.w = __shfl_xor(v[2].w, 4);
              v[2] = (sub < 4) ? (v[2] * cs[u] - pt * sn[u]) : (v[2] * cs[u] + pt * sn[u]);
              bf16_t* kt = Kimg + ((size_t)h * 256 + (m >> 6)) * 6144 + (m & 63) * 8 + (sub & 1) * 4;
#pragma unroll
              for (int c = 0; c < 3; ++c) *(u32x2*)(kt + (4 * c + (sub >> 1)) * 512) = (u32x2){cvtpk(v[c].x, v[c].y), cvtpk(v[c].z, v[c].w)}; }
        }
    }
    for (int it = gw; it < (SEQ / 16) * 2; it += NGW) {
        const int g = it >> 1, hh = it & 1; const int tok0 = g * 16; const float rl = RKV[tok0 + (lane & 15)];
#pragma unroll
        for (int h4 = 0; h4 < 4; ++h4) { const int hd = hh * 4 + h4;
#pragma unroll
            for (int hi = 0; hi < 2; ++hi) { float e[8];
#pragma unroll
                for (int j = 0; j < 8; ++j) { const int t = 8 * (j >> 2) + 4 * hi + (j & 3); e[j] = bf2f(KVP[(size_t)(tok0 + t) * 1024 + 512 + hd * 64 + lane]) * __shfl(rl, t); }
                *(u32x4*)(Vimg + ((size_t)hd * 256 + (g >> 2)) * 4096 + ((size_t)((g & 3) * 2 + hi) * 64 + lane) * 8) = (u32x4){cvtpk(e[0], e[1]), cvtpk(e[2], e[3]), cvtpk(e[4], e[5]), cvtpk(e[6], e[7])}; } }
    }
}

constexpr int AT_BUF = 20480;
constexpr float ATT_THR = 8.f;
__device__ __forceinline__ float max3f(float a, float b, float c) { float r; asm("v_max3_f32 %0, %1, %2, %3" : "=v"(r) : "v"(a), "v"(b), "v"(c)); return r; }
__device__ __forceinline__ float max2f(float a, float b) { float r; asm("v_max_f32_e32 %0, %1, %2" : "=v"(r) : "v"(a), "v"(b)); return r; }
__device__ __forceinline__ float halfmax(float m) { auto rr = __builtin_amdgcn_permlane32_swap(__float_as_uint(m), __float_as_uint(m), false, false); return max2f(__uint_as_float(rr[0]), __uint_as_float(rr[1])); }
__device__ __forceinline__ const char* uniform_ptr(const char* p) { const unsigned long long v = (unsigned long long)p; const unsigned lo = __builtin_amdgcn_readfirstlane((unsigned)v), hi = __builtin_amdgcn_readfirstlane((unsigned)(v >> 32)); return (const char*)(((unsigned long long)hi << 32) | lo); }
#define AT_BAR() do { __builtin_amdgcn_sched_barrier(0); asm volatile("s_waitcnt lgkmcnt(0)\n\ts_barrier" ::: "memory"); __builtin_amdgcn_sched_barrier(0); } while (0)
#define AT_VM(N) asm volatile("s_waitcnt vmcnt(" #N ")" ::: "memory")
__device__ __forceinline__ void attn_phase(LAS unsigned char* lds, const bf16_t* Qb, const bf16_t* Kimg, const bf16_t* Vimg, bf16_t* AB, int bid, int G, int wave_k) {
    const int tid = fresh_tid(wave_k);
    const int lane = tid & 63, r32 = lane & 31, hi = lane >> 5; const int wid = __builtin_amdgcn_readfirstlane(tid >> 6);
    const bool grpB = wid >= 4;
    const unsigned lane16 = (unsigned)lane * 16u;
    const unsigned frag = (unsigned)(hi * 1024 + r32 * 16);
    for (int u = bid; u < NH * (SEQ / 512); u += G) {
        const int h = u & 7, qb = u >> 3; const int qrow0 = qb * 512 + wid * 64;
        bf16x8 qr[2][6];
        { int lq = lane; asm volatile("" : "+v"(lq));
          const char* qbase = (const char*)(Qb + ((size_t)h * SEQ + qrow0) * QKH); const unsigned qoff = (unsigned)((lq & 31) * (QKH * 2) + 16 * (lq >> 5));
#pragma unroll
          for (int b = 0; b < 2; ++b)
#pragma unroll
            for (int d0 = 0; d0 < 6; ++d0) qr[b][d0] = *(const bf16x8*)(qbase + qoff + (unsigned)(32 * b * (QKH * 2) + 32 * d0)); }
        const char* Kt = (const char*)(Kimg + (size_t)h * 256 * 6144); const char* Vt = (const char*)(Vimg + (size_t)h * 256 * 4096);
        const char* g0 = Kt + wid * 1024; const char* g1 = (wid < 4) ? Kt + (wid + 8) * 1024 : Vt + (wid - 4) * 1024; const char* g2 = Vt + (wid + 4) * 1024;
        const int l0 = wid * 1024, l1 = (wid < 4) ? (wid + 8) * 1024 : 12288 + (wid - 4) * 1024, l2 = 12288 + (wid + 4) * 1024;
        const size_t s0 = 12288, s1 = (wid < 4) ? 12288 : 8192, s2 = 8192;
#define AT_ISSUE(t, boff) do { \
            __builtin_amdgcn_global_load_lds((const unsigned*)(uniform_ptr(g0 + (size_t)(t) * s0) + lane16), (LAS unsigned*)(lds + (boff) + l0), 16, 0, 0); \
            __builtin_amdgcn_global_load_lds((const unsigned*)(uniform_ptr(g1 + (size_t)(t) * s1) + lane16), (LAS unsigned*)(lds + (boff) + l1), 16, 0, 0); \
            if (wid < 4) __builtin_amdgcn_global_load_lds((const unsigned*)(uniform_ptr(g2 + (size_t)(t) * s2) + lane16), (LAS unsigned*)(lds + (boff) + l2), 16, 0, 0); } while (0)
        float mhat[2] = {0.f, 0.f}, lrun[2] = {0.f, 0.f}; f32x16 o[2][2], negm[2], p[2]; bf16x8 pf[2][2];
#pragma unroll
        for (int b = 0; b < 2; ++b)
#pragma unroll
            for (int r = 0; r < 16; ++r) { o[b][0][r] = 0.f; o[b][1][r] = 0.f; negm[b][r] = 0.f; }
#pragma unroll
        for (int b = 0; b < 2; ++b) for (int s2 = 0; s2 < 2; ++s2) for (int e = 0; e < 8; ++e) pf[b][s2][e] = 0;
#define AT_MSEG(kboff, kb2, vboff, sbase) do { \
            const LAS unsigned char* kbase_ = lds + (kboff) + frag + (kb2) * 512; const LAS unsigned char* vb_ = lds + (vboff) + 12288 + frag + (sbase) * 2048; \
            bf16x8 kf[6], vf[2][2]; \
            _Pragma("unroll") for (int d0 = 0; d0 < 6; ++d0) kf[d0] = *(const LAS bf16x8*)(kbase_ + d0 * 2048); \
            _Pragma("unroll") for (int s2 = 0; s2 < 2; ++s2) { vf[s2][0] = *(const LAS bf16x8*)(vb_ + s2 * 2048); vf[s2][1] = *(const LAS bf16x8*)(vb_ + s2 * 2048 + 512); } \
            __builtin_amdgcn_sched_barrier(0);     \
            _Pragma("unroll") for (int d0 = 0; d0 < 6; ++d0) \
                _Pragma("unroll") for (int b = 0; b < 2; ++b) p[b] = __builtin_amdgcn_mfma_f32_32x32x16_bf16(kf[d0], qr[b][d0], d0 == 0 ? negm[b] : p[b], 0, 0, 0); \
            __builtin_amdgcn_sched_barrier(0);     \
            _Pragma("unroll") for (int s2 = 0; s2 < 2; ++s2) \
                _Pragma("unroll") for (int b = 0; b < 2; ++b) { o[b][0] = __builtin_amdgcn_mfma_f32_32x32x16_bf16(vf[s2][0], pf[b][s2], o[b][0], 0, 0, 0); o[b][1] = __builtin_amdgcn_mfma_f32_32x32x16_bf16(vf[s2][1], pf[b][s2], o[b][1], 0, 0, 0); } } while (0)
#define AT_PV(boff, sbase) do { const LAS unsigned char* vb_ = lds + (boff) + 12288 + frag + (sbase) * 2048; \
            _Pragma("unroll") for (int s2 = 0; s2 < 2; ++s2) { const bf16x8 v0 = *(const LAS bf16x8*)(vb_ + s2 * 2048), v1 = *(const LAS bf16x8*)(vb_ + s2 * 2048 + 512); \
                _Pragma("unroll") for (int b = 0; b < 2; ++b) { o[b][0] = __builtin_amdgcn_mfma_f32_32x32x16_bf16(v0, pf[b][s2], o[b][0], 0, 0, 0); o[b][1] = __builtin_amdgcn_mfma_f32_32x32x16_bf16(v1, pf[b][s2], o[b][1], 0, 0, 0); } } } while (0)
#define AT_SM(FIRST) do { \
            asm volatile("s_nop 3" : "+v"(p[0]), "+v"(p[1]));     \
            float rm[2]; \
            _Pragma("unroll") for (int b = 0; b < 2; ++b) { float a = max3f(p[b][0], p[b][1], p[b][2]), c = max3f(p[b][3], p[b][4], p[b][5]); \
                a = max3f(a, p[b][6], p[b][7]); c = max3f(c, p[b][8], p[b][9]); a = max3f(a, p[b][10], p[b][11]); c = max3f(c, p[b][12], p[b][13]); a = max3f(a, p[b][14], p[b][15]); \
                rm[b] = max2f(a, c); }     \
            if ((FIRST) || __any(__float_as_int(max2f(rm[0], rm[1])) > __float_as_int(ATT_THR))) {     \
                _Pragma("unroll") for (int b = 0; b < 2; ++b) { rm[b] = halfmax(rm[b]); const float dl = (FIRST) ? rm[b] : fmaxf(rm[b], 0.f); mhat[b] += dl; const float f = (FIRST) ? 1.f : __builtin_amdgcn_exp2f(-dl); lrun[b] *= f; \
                    _Pragma("unroll") for (int r = 0; r < 16; ++r) { p[b][r] -= dl; negm[b][r] = -mhat[b]; o[b][0][r] *= f; o[b][1][r] *= f; } } \
            } \
            _Pragma("unroll") for (int b = 0; b < 2; ++b) {     \
                _Pragma("unroll") for (int r = 0; r < 16; ++r) { p[b][r] = __builtin_amdgcn_exp2f(p[b][r]); lrun[b] += p[b][r]; } \
                _Pragma("unroll") for (int s2 = 0; s2 < 2; ++s2) { const f32x16& x = p[b]; const int o8 = 8 * s2; \
                    pf[b][s2] = __builtin_bit_cast(bf16x8, (u32x4){cvtpk(x[o8], x[o8 + 1]), cvtpk(x[o8 + 2], x[o8 + 3]), cvtpk(x[o8 + 4], x[o8 + 5]), cvtpk(x[o8 + 6], x[o8 + 7])}); } } \
            asm volatile("" : "+v"(pf[0][0]), "+v"(pf[0][1]), "+v"(pf[1][0]), "+v"(pf[1][1]), "+v"(lrun[0]), "+v"(lrun[1]));     \
            } while (0)
#define AT_PIN_M() asm volatile("" : "+v"(p[0]), "+v"(p[1]), "+v"(o[0][0]), "+v"(o[0][1]), "+v"(o[1][0]), "+v"(o[1][1]))
        int b_prev = 2 * AT_BUF, b_cur = 0, b_next = AT_BUF;
        AT_ISSUE(0, 0); AT_ISSUE(1, AT_BUF);
        asm volatile("s_waitcnt vmcnt(0)" ::: "memory"); AT_BAR();
        if (grpB) AT_BAR();
        for (int t = 0; t < 256; ++t) {
            AT_MSEG(b_cur, 0, (t > 0 ? b_prev : b_cur), 2);
            AT_PIN_M();
            AT_BAR();
            AT_SM(t == 0);
            AT_BAR();
            const bool issued = (t + 2 < 256);
            if (issued) AT_ISSUE(t + 2, b_prev);
            AT_MSEG(b_cur, 1, b_cur, 0);
            AT_PIN_M();
            if (grpB) { if (issued) AT_VM(2); else AT_VM(0); }
            AT_BAR();
            AT_SM(false);
            if (!grpB) { if (issued) AT_VM(3); else AT_VM(0); }
            AT_BAR();
            const int tmp = b_prev; b_prev = b_cur; b_cur = b_next; b_next = tmp;
        }
        AT_PV(b_prev, 2);
        if (!grpB) AT_BAR();
        AT_BAR();
#undef AT_ISSUE
#undef AT_MSEG
#undef AT_PV
#undef AT_SM
#undef AT_PIN_M
        int lane_o = lane; asm volatile("" : "+v"(lane_o));
#pragma unroll
        for (int b = 0; b < 2; ++b) { const float lt = lrun[b] + __shfl_xor(lrun[b], 32), il = 1.f / lt;
            bf16_t* orow = AB + (size_t)(qrow0 + 32 * b + (lane_o & 31)) * DM + h * VH + 4 * (lane_o >> 5);
#pragma unroll
            for (int g = 0; g < 4; ++g) {
                *(u32x2*)(orow + 8 * g) = (u32x2){cvtpk(o[b][0][4 * g] * il, o[b][0][4 * g + 1] * il), cvtpk(o[b][0][4 * g + 2] * il, o[b][0][4 * g + 3] * il)};
                *(u32x2*)(orow + 32 + 8 * g) = (u32x2){cvtpk(o[b][1][4 * g] * il, o[b][1][4 * g + 1] * il), cvtpk(o[b][1][4 * g + 2] * il, o[b][1][4 * g + 3] * il)}; } }
    }
}

typedef const __attribute__((address_space(4))) Args* KArgs;
__device__ __forceinline__ KArgs fresh_args() { KArgs p = (KArgs)__builtin_amdgcn_kernarg_segment_ptr(); asm volatile("" : "+s"(p)); return p; }
#define PH_BEGIN() KArgs ap = fresh_args(); unsigned char* ws = ap->ws; float* X = ap->out; (void)X; \
    bf16_t* Wb = (bf16_t*)(ws + ((l & 1) ? WS_W2 : WS_W)); bf16_t* Wnext = (bf16_t*)(ws + ((l & 1) ? WS_W : WS_W2)); (void)Wnext; bf16_t* HN = (bf16_t*)(ws + WS_HN); bf16_t* ACT = (bf16_t*)(ws + WS_ACT); \
    bf16_t* QP = (bf16_t*)(ws + WS_QP); bf16_t* KVP = (bf16_t*)(ws + WS_KVP); bf16_t* ZCb = (bf16_t*)(ws + WS_ZC); float* ZRb = (float*)(ws + WS_ZR); \
    bf16_t* MIX = (bf16_t*)(ws + WS_MIX); float* RQ = (float*)(ws + WS_RQ); float* RKV = (float*)(ws + WS_RKV); float* ROPE = (float*)(ws + WS_ROPE); u64* SSb = (u64*)(ws + WS_SS); (void)SSb; \
    bf16_t* Qb = (bf16_t*)(ws + WS_Q); bf16_t* Kimg = (bf16_t*)(ws + WS_K); bf16_t* Vimg = (bf16_t*)(ws + WS_V); bf16_t* AB = (bf16_t*)(ws + WS_AB); \
    (void)Wb; (void)HN; (void)ACT; (void)QP; (void)KVP; (void)ZCb; (void)ZRb; (void)MIX; (void)RQ; (void)RKV; (void)ROPE; (void)Qb; (void)Kimg; (void)Vimg; (void)AB; \
    const int tid = fresh_tid(wave_k); int bid = blockIdx.x, G = gridDim.x; asm volatile("" : "+s"(bid), "+s"(G)); const int lane = tid & 63, wave = __builtin_amdgcn_readfirstlane(tid >> 6), NGW = G * 8, gw = bid * 8 + wave; \
    (void)lane; (void)gw; (void)NGW; pg8::StaticOrder S; (void)S

__global__ void __launch_bounds__(512, 2) fwd_kernel(Args a_unused) {
    extern __shared__ __attribute__((aligned(16))) unsigned char lds_raw[];
    LAS unsigned char* lds = (LAS unsigned char*)lds_raw;
    cg::grid_group grid = cg::this_grid();
    const int wave_k = __builtin_amdgcn_readfirstlane((int)(threadIdx.x >> 6));
    volatile LAS unsigned* bst = (volatile LAS unsigned*)(lds + 131072);
    if (threadIdx.x < 2) bst[threadIdx.x] = 0u;
    __syncthreads();
    XcdBarrier xbar; { KArgs ap0 = fresh_args(); xbar = xcd_barrier_post((unsigned*)(ap0->ws + WS_CTL), bst); }
#define GSYNC() xcd_barrier(xbar)
    for (int l = 0; l < DEPTH; ++l) {
        if (l == 0) { PH_BEGIN(); convert_weights(ap, l, Wb, lds, gw, NGW, wave, lane, -1);
          { rope_table(ROPE, bid * 512 + tid, G * 512); init_rows(ap->in[0], HN, SSb, X, gw, NGW, lane);
              for (int i = bid * 512 + tid; i < DEPTH * 3 * SEQ; i += G * 512) __hip_atomic_store(SSb + SEQ + i, (u64)0, __ATOMIC_RELAXED, __HIP_MEMORY_SCOPE_AGENT); } }
        if (l == 0) grid.sync();
        { PH_BEGIN(); pg8::Gemm g{HN, Wb + O_WGU1, SEQ, 2 * DFF, DM, DM}; S.init(SEQ, 2 * DFF, G, bid); pg8::EpiSwiGLU E{ACT, SSb + (size_t)(3 * l) * SEQ}; pg8::gemm_phase(lds, g, S, E, wave_k);
          if (l + 1 < DEPTH && bid >= G / 2) convert_weights(ap, l + 1, Wnext, lds, (bid - G / 2) * 8 + wave, (G - G / 2) * 8, wave, lane, 0); }
        GSYNC();
        { PH_BEGIN(); pg8::Gemm g{ACT, Wb + O_WD1, SEQ, DM, DFF, DFF}; S.init(SEQ, DM, G, bid); pg8::EpiResid E{l == 0 ? ap->in[0] : (const float*)X, X, HN, SSb + (size_t)(3 * l + 1) * SEQ, 0.5f}; pg8::gemm_phase(lds, g, S, E, wave_k); }
        GSYNC();
        { PH_BEGIN(); pg8::Gemm g{HN, Wb + O_WIN, SEQ, DINP, DM, DM}; S.init(SEQ, DINP, G, bid); pg8::EpiZ E{ZCb, ZRb, SSb + (size_t)(3 * l + 1) * SEQ}; pg8::gemm_phase(lds, g, S, E, wave_k); }
        GSYNC();
        { PH_BEGIN(); rowstats_mixed(ZCb, ZRb, RQ, RKV, MIX, gw, NGW, lane); }
        { PH_BEGIN(); pg8::Gemm g{ZCb, Wb + O_WUQ, SEQ, 768, QL, ZC}; S.init(SEQ, 768, G, bid); pg8::EpiB16 E{QP, 768}; pg8::gemm_phase(lds, g, S, E, wave_k); }
        { PH_BEGIN(); pg8::Gemm g{ZCb + QL, Wb + O_WUKV, SEQ, 1024, KVL, ZC}; S.init(SEQ, 1024, G, bid); pg8::EpiB16 E{KVP, 1024}; pg8::gemm_phase(lds, g, S, E, wave_k); }
        GSYNC();
        { PH_BEGIN(); finalize_qkv(QP, KVP, ZRb, RQ, RKV, ROPE, ap->in[11] + (size_t)l * QKH, ap->in[12] + (size_t)l * QKH, Qb, Kimg, Vimg, gw, NGW, lane); }
        { PH_BEGIN(); pg8::Gemm g{MIX, Wb + O_WPOOL, SEQ, PW, PW, PW}; S.init(SEQ, PW, G, bid); pg8::EpiPool E{AB, ap->in[14] + (size_t)l * PW}; pg8::gemm_phase(lds, g, S, E, wave_k); }
        GSYNC();
        { PH_BEGIN(); attn_phase(lds, Qb, Kimg, Vimg, AB, bid, G, wave_k); }
        GSYNC();
        { PH_BEGIN(); pg8::Gemm g{AB, Wb + O_WOUT, SEQ, DM, DM, DM}; S.init(SEQ, DM, G, bid); pg8::EpiResid E{X, X, HN, SSb + (size_t)(3 * l + 2) * SEQ, 1.0f}; pg8::gemm_phase(lds, g, S, E, wave_k); }
        GSYNC();
        { PH_BEGIN(); pg8::Gemm g{HN, Wb + O_WGU2, SEQ, 2 * DFF, DM, DM}; S.init(SEQ, 2 * DFF, G, bid); pg8::EpiSwiGLU E{ACT, SSb + (size_t)(3 * l + 2) * SEQ}; pg8::gemm_phase(lds, g, S, E, wave_k);
          if (l + 1 < DEPTH && bid >= G / 2) convert_weights(ap, l + 1, Wnext, lds, (bid - G / 2) * 8 + wave, (G - G / 2) * 8, wave, lane, 1); }
        GSYNC();
        { PH_BEGIN(); pg8::Gemm g{ACT, Wb + O_WD2, SEQ, DM, DFF, DFF}; S.init(SEQ, DM, G, bid); pg8::EpiResid E{X, X, HN, SSb + (size_t)(3 * l + 3) * SEQ, 0.5f}; pg8::gemm_phase(lds, g, S, E, wave_k); }
        if (l + 1 < DEPTH) GSYNC();
    }
}

extern "C" void kernel_launch(void* const* d_in, const int* in_sizes, int n_in, void* d_out, int out_size, void* d_ws, size_t ws_size, hipStream_t stream) {
    static int grid = 0;
    if (grid == 0) {
        if (n_in != 19 || out_size != SEQ * DM || ws_size < WS_END) { fprintf(stderr, "kernel_launch: unexpected shapes (n_in %d out %d ws %zu need %zu)\n", n_in, out_size, ws_size, (size_t)WS_END); grid = -1; return; }
        int dev = 0, cus = 0, per_cu = 0;
        hipGetDevice(&dev); hipDeviceGetAttribute(&cus, hipDeviceAttributeMultiprocessorCount, dev);
        hipFuncSetAttribute((const void*)fwd_kernel, hipFuncAttributeMaxDynamicSharedMemorySize, LDS_BYTES);
        hipOccupancyMaxActiveBlocksPerMultiprocessor(&per_cu, (const void*)fwd_kernel, 512, LDS_BYTES);
        if (per_cu < 1) { fprintf(stderr, "kernel_launch: occupancy query says %d blocks per CU\n", per_cu); }
        (void)hipGetLastError();
        grid = cus > 0 ? cus : 256;
    }
    if (grid < 0) return;
    if (hipMemsetAsync((char*)d_ws + WS_CTL, 0, CTL_BYTES, stream) != hipSuccess) { fprintf(stderr, "kernel_launch: memset failed\n"); return; }
    Args a{};
    for (int i = 0; i < 19; ++i) a.in[i] = (const float*)d_in[i];
    a.out = (float*)d_out; a.ws = (unsigned char*)d_ws;
    void* args[] = {&a};
    hipError_t e = hipLaunchCooperativeKernel((const void*)fwd_kernel, dim3(grid), dim3(512), args, LDS_BYTES, stream);
    if (e != hipSuccess) fprintf(stderr, "cooperative launch failed: %s (grid %d)\n", hipGetErrorString(e), grid);
}
```
